# Optimizing an MI355X kernel written in HIP

```python
import math
import jax
import jax.numpy as jnp
from jax import lax
import numpy as np

D_MODEL = 1024
BATCH = 8
SEQ = 4096
DEPTH = 2

D_MIX = D_MODEL
N_MIXERS = 4
GROUP_W = D_MIX // N_MIXERS
HEAD_DIM = 64
A_HEADS = GROUP_W // HEAD_DIM
A_KV_HEADS = A_HEADS // 2
C_HEADS = GROUP_W // HEAD_DIM
C_SUB = HEAD_DIM // 2
HY_EMB = 33
HY_BANDS = (HY_EMB - 1) // 2
HY_FFN = 64
HY_SHIFT = 0.05
HY_FAST = 0.3
HY_SLOW = 1.5
HY_TARGET = 1e-2
CONV_W = 3
GRID_W = 64
ROPE_THETA = 10000.0
Q_BLOCK = 128
EPS = 1e-6

SPLIT_SIZES = (
    A_HEADS * HEAD_DIM, A_KV_HEADS * HEAD_DIM, A_KV_HEADS * HEAD_DIM, GROUP_W,
    3 * GROUP_W, GROUP_W,
    2 * C_HEADS * C_SUB, 2 * C_HEADS * C_SUB, C_HEADS * HEAD_DIM, GROUP_W,
    3 * GROUP_W, GROUP_W,
)
D_IN = sum(SPLIT_SIZES)
SPLIT_POINTS = tuple(sum(SPLIT_SIZES[:i + 1]) for i in range(len(SPLIT_SIZES) - 1))

kernel_name = "hymba_style_bidir_hybrid_encoder"


def rmsnorm(x, g):
    xf = x.astype(jnp.float32)
    y = xf * lax.rsqrt(jnp.mean(xf * xf, axis=-1, keepdims=True) + EPS)
    return (y * g.astype(jnp.float32)).astype(x.dtype)


def rope_cos_sin(pos, dim):
    inv = ROPE_THETA ** (-jnp.arange(0, dim, 2, dtype=jnp.float32) / dim)
    ang = pos.astype(jnp.float32)[:, None] * inv[None, :]
    return jnp.cos(ang), jnp.sin(ang)


def apply_rope(x, cs):
    cos, sin = cs
    xf = x.astype(jnp.float32)
    x1, x2 = jnp.split(xf, 2, axis=-1)
    c, s = cos[:, None, :], sin[:, None, :]
    return jnp.concatenate([x1 * c - x2 * s, x2 * c + x1 * s], axis=-1).astype(x.dtype)


def apply_axial_rope(x, cs_row, cs_col):
    xr, xc = jnp.split(x, 2, axis=-1)
    return jnp.concatenate([apply_rope(xr, cs_row), apply_rope(xc, cs_col)], axis=-1)


def dwconv3(x, w, b=None):
    xp = jnp.pad(x, ((0, 0), (1, 1), (0, 0)))
    y = xp[:, :-2] * w[0] + xp[:, 1:-1] * w[1] + xp[:, 2:] * w[2]
    return y if b is None else y + b


def to_blocks(q):
    b, s = q.shape[:2]
    q = q.reshape((b, s // Q_BLOCK, Q_BLOCK) + q.shape[2:])
    return jnp.moveaxis(q, 1, 0)


def from_blocks(o):
    o = jnp.moveaxis(o, 0, 1)
    return o.reshape((o.shape[0], o.shape[1] * o.shape[2]) + o.shape[3:])


def gqa_attention(q, k, v):
    b, s, hq, d = q.shape
    hkv = k.shape[2]
    qg = q.reshape(b, s, hkv, hq // hkv, d)
    scale = d ** -0.5

    def block(qb):
        sc = jnp.einsum('bqhgd,bshd->bhgqs', qb, k, preferred_element_type=jnp.float32) * scale
        p = jax.nn.softmax(sc, axis=-1).astype(v.dtype)
        return jnp.einsum('bhgqs,bshd->bqhgd', p, v)

    o = from_blocks(lax.map(block, to_blocks(qg)))
    return o.reshape(b, s, hq * d)


def diff_attention(q, k, v, lam):
    scale = q.shape[-1] ** -0.5

    def block(qb):
        sc = jnp.einsum('bqhcd,bshcd->bhcqs', qb, k, preferred_element_type=jnp.float32) * scale
        p = jax.nn.softmax(sc, axis=-1)
        w = (p[:, :, 0] - lam * p[:, :, 1]).astype(v.dtype)
        return jnp.einsum('bhqs,bshd->bqhd', w, v)

    return from_blocks(lax.map(block, to_blocks(q)))


def hyena_filter(L, w1, b1, freq, w2, b2, w3):
    f32 = jnp.float32
    t = jnp.linspace(0.0, 1.0, L, dtype=f32)[:, None]
    w = 2.0 * math.pi * jnp.arange(L, dtype=f32)[:, None] / L
    f = jnp.linspace(1e-4, HY_BANDS - 1, HY_BANDS, dtype=f32)[None, :]
    emb = jnp.concatenate([t, jnp.cos(f * w), -jnp.sin(f * w)], axis=-1)
    fr = freq.astype(f32)
    h = jnp.sin(fr * (emb @ w1.astype(f32) + b1.astype(f32)))
    h = jnp.sin(fr * (h @ w2.astype(f32) + b2.astype(f32)))
    h = h @ w3.astype(f32)
    max_decay = math.log(HY_TARGET) / HY_FAST
    min_decay = math.log(HY_TARGET) / HY_SLOW
    deltas = jnp.linspace(min_decay, max_decay, GROUP_W, dtype=f32)
    window = jnp.exp(-t * jnp.abs(deltas)[None, :]) + HY_SHIFT
    h_fwd = h[:, :GROUP_W] * window
    h_bwd = h[:, GROUP_W:] * window
    kern = jnp.concatenate([h_fwd, jnp.zeros((1, GROUP_W), f32), h_bwd[:0:-1]], axis=0)
    return kern / jnp.sum(jnp.abs(kern), axis=0, keepdims=True)


def bidir_fftconv(z, kern, bias):
    L = z.shape[1]
    n = 2 * L
    zf32 = z.astype(jnp.float32)
    zf = jnp.fft.rfft(zf32, n=n, axis=1)
    kf = jnp.fft.rfft(kern, n=n, axis=0)
    y = jnp.fft.irfft(zf * kf[None], n=n, axis=1)[:, :L]
    return (y + bias.astype(jnp.float32) * zf32).astype(z.dtype)


def hybrid_layer(x, c, layer_idx, cs_row, cs_col, cs_seq, norm_g, w_ada, b_ada, w_in, w_out,
                 a_qn, a_kn, hy_conv_w, hy_conv_b, hy_w1, hy_b1, hy_freq, hy_w2, hy_b2, hy_w3,
                 hy_bias, c_qn, c_kn, lam_q1, lam_k1, lam_q2, lam_k2, c_subln, sc_conv_w):
    b, s, _ = x.shape
    mod = jax.nn.silu(c) @ w_ada + b_ada
    shift, scale, gate = jnp.split(mod, 3, axis=-1)
    h = rmsnorm(x, norm_g) * (1.0 + scale[:, None, :]) + shift[:, None, :]
    proj = h @ w_in
    (a_q, a_k, a_v, a_g, b_p, b_g, c_q, c_k, c_v, c_g, d_p, d_g) = jnp.split(proj, SPLIT_POINTS, axis=-1)

    qa = apply_axial_rope(rmsnorm(a_q.reshape(b, s, A_HEADS, HEAD_DIM), a_qn), cs_row, cs_col)
    ka = apply_axial_rope(rmsnorm(a_k.reshape(b, s, A_KV_HEADS, HEAD_DIM), a_kn), cs_row, cs_col)
    va = a_v.reshape(b, s, A_KV_HEADS, HEAD_DIM)
    y_a = jax.nn.silu(a_g) * gqa_attention(qa, ka, va)

    x0, x1, vb = jnp.split(dwconv3(b_p, hy_conv_w, hy_conv_b), 3, axis=-1)
    kern = hyena_filter(s, hy_w1, hy_b1, hy_freq, hy_w2, hy_b2, hy_w3)
    y_b = jax.nn.silu(b_g) * (x0 * bidir_fftconv(x1 * vb, kern, hy_bias))

    qc = apply_rope(rmsnorm(c_q.reshape(b, s, 2 * C_HEADS, C_SUB), c_qn), cs_seq).reshape(b, s, C_HEADS, 2, C_SUB)
    kc = apply_rope(rmsnorm(c_k.reshape(b, s, 2 * C_HEADS, C_SUB), c_kn), cs_seq).reshape(b, s, C_HEADS, 2, C_SUB)
    vc = c_v.reshape(b, s, C_HEADS, HEAD_DIM)
    lambda_init = 0.8 - 0.6 * math.exp(-0.3 * layer_idx)
    lam = (jnp.exp(jnp.sum(lam_q1.astype(jnp.float32) * lam_k1.astype(jnp.float32)))
           - jnp.exp(jnp.sum(lam_q2.astype(jnp.float32) * lam_k2.astype(jnp.float32)))
           + lambda_init)
    oc = rmsnorm(diff_attention(qc, kc, vc, lam), c_subln) * (1.0 - lambda_init)
    y_c = jax.nn.silu(c_g) * oc.reshape(b, s, C_HEADS * HEAD_DIM)

    bg, cg, xd = jnp.split(d_p, 3, axis=-1)
    y_d = jax.nn.silu(d_g) * (bg * dwconv3(cg * xd, sc_conv_w))

    out = jnp.concatenate([y_a, y_b, y_c, y_d], axis=-1) @ w_out
    return x + gate[:, None, :] * out


def setup_inputs(seed: int = 0) -> dict:
    key = jax.random.key(seed)
    ks = jax.random.split(key, 26)

    def nrm(k, shape, scale):
        return jax.random.normal(k, shape, jnp.float32) * scale

    def gain(k, shape, noise=0.02):
        return 1.0 + noise * jax.random.normal(k, shape, jnp.float32)

    L = DEPTH
    return {
        'x': nrm(ks[0], (BATCH, SEQ, D_MODEL), 1.0),
        'c': nrm(ks[1], (BATCH, D_MODEL), 1.0),
        'norm_g': gain(ks[2], (L, D_MODEL)),
        'w_ada': nrm(ks[3], (L, D_MODEL, 3 * D_MODEL), 0.5 * D_MODEL ** -0.5),
        'b_ada': nrm(ks[4], (L, 3 * D_MODEL), 0.01),
        'w_in': nrm(ks[5], (L, D_MODEL, D_IN), D_MODEL ** -0.5),
        'w_out': nrm(ks[6], (L, D_MIX, D_MODEL), D_MIX ** -0.5),
        'a_qn': gain(ks[7], (L, HEAD_DIM)),
        'a_kn': gain(ks[8], (L, HEAD_DIM)),
        'hy_conv_w': nrm(ks[9], (L, CONV_W, 3 * GROUP_W), CONV_W ** -0.5),
        'hy_conv_b': nrm(ks[10], (L, 3 * GROUP_W), 0.01),
        'hy_w1': nrm(ks[11], (L, HY_EMB, HY_FFN), HY_EMB ** -0.5),
        'hy_b1': nrm(ks[12], (L, HY_FFN), 0.1),
        'hy_freq': gain(ks[13], (L, HY_FFN), 0.1),
        'hy_w2': nrm(ks[14], (L, HY_FFN, HY_FFN), HY_FFN ** -0.5),
        'hy_b2': nrm(ks[15], (L, HY_FFN), 0.1),
        'hy_w3': nrm(ks[16], (L, HY_FFN, 2 * GROUP_W), HY_FFN ** -0.5),
        'hy_bias': nrm(ks[17], (L, GROUP_W), 1.0),
        'c_qn': gain(ks[18], (L, C_SUB)),
        'c_kn': gain(ks[19], (L, C_SUB)),
        'lam_q1': nrm(ks[20], (L, C_SUB), 0.1),
        'lam_k1': nrm(ks[21], (L, C_SUB), 0.1),
        'lam_q2': nrm(ks[22], (L, C_SUB), 0.1),
        'lam_k2': nrm(ks[23], (L, C_SUB), 0.1),
        'c_subln': gain(ks[24], (L, HEAD_DIM)),
        'sc_conv_w': nrm(ks[25], (L, CONV_W, GROUP_W), CONV_W ** -0.5),
    }


def reference(x, c, norm_g, w_ada, b_ada, w_in, w_out, a_qn, a_kn, hy_conv_w, hy_conv_b,
              hy_w1, hy_b1, hy_freq, hy_w2, hy_b2, hy_w3, hy_bias, c_qn, c_kn,
              lam_q1, lam_k1, lam_q2, lam_k2, c_subln, sc_conv_w):
    s = x.shape[1]
    rows = s // GRID_W
    t = jnp.arange(s, dtype=jnp.int32)
    row = jnp.repeat(jnp.arange(rows, dtype=jnp.int32), GRID_W)
    col = jnp.tile(jnp.arange(GRID_W, dtype=jnp.int32), rows)
    cs_row = rope_cos_sin(row, HEAD_DIM // 2)
    cs_col = rope_cos_sin(col, HEAD_DIM // 2)
    cs_seq = rope_cos_sin(t, C_SUB)
    for l in range(DEPTH):
        x = hybrid_layer(x, c, l, cs_row, cs_col, cs_seq, norm_g[l], w_ada[l], b_ada[l], w_in[l], w_out[l],
                         a_qn[l], a_kn[l], hy_conv_w[l], hy_conv_b[l], hy_w1[l], hy_b1[l], hy_freq[l],
                         hy_w2[l], hy_b2[l], hy_w3[l], hy_bias[l], c_qn[l], c_kn[l],
                         lam_q1[l], lam_k1[l], lam_q2[l], lam_k2[l], c_subln[l], sc_conv_w[l])
    return x
```

```cpp
#include <hip/hip_cooperative_groups.h>
#include <hip/hip_runtime.h>
#include <cstdio>
#include <cstdint>
__device__ __forceinline__ int fresh_tid() { int t = threadIdx.x; asm volatile("" : "+v"(t)); return t; }
namespace pg8 {
#define PG8_LAS __attribute__((address_space(3)))
typedef unsigned short bf16_t;
typedef short bf16x8 __attribute__((ext_vector_type(8)));
typedef float f32x4 __attribute__((ext_vector_type(4)));
typedef unsigned u32x4 __attribute__((ext_vector_type(4)));
constexpr int BM = 256, BK = 64, HALF = 128, HTB = HALF * BK * 2  , STAGE_BYTES = 8 * HTB, NXCD = 8, WGM = 8;

__host__ __device__ __forceinline__ int lds_byte(int r, int c) { const int st = (r >> 4) * 2 + (c >> 5), rr = r & 15, cc = c & 31, ob = rr * 64 + cc * 2; return st * 1024 + (ob ^ (((ob >> 9) & 1) << 5)); }
__host__ __device__ __forceinline__ void stage_rc(int b, int& R, int& C) { const int st = b / 1024, sb = b % 1024, swz = sb ^ (((sb >> 9) & 1) << 5); R = (st >> 1) * 16 + swz / 64; C = (st & 1) * 32 + (swz % 64) / 2; }
__host__ __device__ __forceinline__ int perm32(int rho) { const int n = rho >> 4, i = rho & 15; return 8 * (i >> 2) + 4 * n + (i & 3); }

struct Unit { int pm, pn; };
struct Gemm { const bf16_t* A; const bf16_t* Bt; int M, N, K; };

struct StaticOrder {
    int nM, nN, nwg, G, c;
    __host__ __device__ void init(int M, int N, int G_, int c_) { nM = M / BM; nN = N / BM; nwg = nM * nN; G = G_; c = c_; }
    __host__ __device__ bool next(int i, Unit& u) const {
        const long L = (long)i * G + c; if (L >= nwg) return false;
        int wgid = (int)L; { const int q = nwg / NXCD, r = nwg % NXCD, xcd = wgid % NXCD, off = wgid / NXCD; wgid = (xcd < r ? xcd * (q + 1) : r * (q + 1) + (xcd - r) * q) + off; }
        const int nig = WGM * nN, gid = wgid / nig, fm = gid * WGM, gsz = (nM - fm) < WGM ? (nM - fm) : WGM;
        u.pm = fm + ((wgid % nig) % gsz); u.pn = (wgid % nig) / gsz; return true;
    }
    __device__ __forceinline__ void a_ready(const Unit&) const {}
    __device__ __forceinline__ void done(const Unit&) const {}
};

__device__ __forceinline__ unsigned cvt_pk_bf16(float lo, float hi) { unsigned r; asm volatile("v_cvt_pk_bf16_f32 %0, %1, %2" : "=v"(r) : "v"(lo), "v"(hi)); return r; }
typedef float f32x2 __attribute__((ext_vector_type(2)));
__device__ __forceinline__ f32x2 gelu_pk(f32x2 v) {
    const f32x2 av = __builtin_elementwise_abs(v), d = av * 0.2316418882f + 1.0f;
    f32x2 t; t.x = __builtin_amdgcn_rcpf(d.x); t.y = __builtin_amdgcn_rcpf(d.y);
    f32x2 q = t * 0.5307027145f + (-0.7265760135f); q = q * t + 0.7107068705f; q = q * t + (-0.142248368f); q = q * t + 0.127414796f; q = q * t;
    const f32x2 s = (v * v) * (-0.72134752044f);
    f32x2 e; e.x = __builtin_amdgcn_exp2f(s.x); e.y = __builtin_amdgcn_exp2f(s.y);
    const f32x2 m = v * (q * e), r = v - m;
    f32x2 o; o.x = v.x < 0.f ? m.x : r.x; o.y = v.y < 0.f ? m.y : r.y; return o;
}

template <int ACT  > struct EpiBf16 {
    static constexpr bool PERM = true, AFTER_DRAIN = false; static_assert(ACT == 0 || ACT == 1, "EpiBf16: ACT is 0 (none) or 1 (gelu_pk)");
    bf16_t* O; int ldc; const float* bias; int split_cols; size_t split_stride; float scale0;
    __device__ __forceinline__ void operator()(const f32x4 (&acc)[2][2][4][2], const Unit& u, int wr, int wc, int fr, int fq) const {
        const int row0 = u.pm * BM + wr * 64 + fr; int colt = u.pn * BM; bf16_t* base = O;
        float sc = 1.f; if (split_cols) { const int t = colt / split_cols; base += (size_t)t * split_stride; colt -= t * split_cols; if (t == 0) sc = scale0; }
        const int col0 = colt + wc * 32 + 8 * fq, bcol0 = u.pn * BM + wc * 32 + 8 * fq;
        f32x4 bv[2][2];
#pragma unroll
        for (int bj = 0; bj < 2; ++bj)
#pragma unroll
            for (int n = 0; n < 2; ++n) bv[bj][n] = bias ? *(const f32x4*)(bias + bcol0 + bj * HALF + 4 * n) : (f32x4){0.f, 0.f, 0.f, 0.f};
#pragma unroll
        for (int ai = 0; ai < 2; ++ai)
#pragma unroll
            for (int m = 0; m < 4; ++m) { bf16_t* rowp = base + (size_t)(row0 + ai * HALF + m * 16) * ldc + col0;
#pragma unroll
                for (int bj = 0; bj < 2; ++bj) { f32x4 v0 = acc[ai][bj][m][0] + bv[bj][0], v1 = acc[ai][bj][m][1] + bv[bj][1];
                    if (ACT == 1) { f32x2 a = gelu_pk((f32x2){v0[0], v0[1]}), b = gelu_pk((f32x2){v0[2], v0[3]}), c = gelu_pk((f32x2){v1[0], v1[1]}), d = gelu_pk((f32x2){v1[2], v1[3]});
                        v0 = (f32x4){a.x, a.y, b.x, b.y}; v1 = (f32x4){c.x, c.y, d.x, d.y}; }
                    v0 = v0 * sc; v1 = v1 * sc; u32x4 w; w.x = cvt_pk_bf16(v0[0], v0[1]); w.y = cvt_pk_bf16(v0[2], v0[3]); w.z = cvt_pk_bf16(v1[0], v1[1]); w.w = cvt_pk_bf16(v1[2], v1[3]);
                    *(u32x4*)(rowp + bj * HALF) = w; } }
    }
};
template <class Epi, class Sched, bool ALIGN_EPI = false, bool SP2 = false>
__device__ __forceinline__ void gemm_phase(PG8_LAS unsigned char* lds, const Gemm g, const Sched& S, const Epi& E) {
    const int tid = fresh_tid(), wid = __builtin_amdgcn_readfirstlane(tid >> 6), lane = tid & 63, wr = wid >> 2, wc = wid & 3, fr = lane & 15, fq = lane >> 4;
    const int K = g.K, nt = K / BK;
    unsigned voffA[2], voffB[2];
#pragma unroll
    for (int i = 0; i < 2; ++i) { int R, C; stage_rc(tid * 16 + i * 8192, R, C); const int Rb = Epi::PERM ? ((R & ~31) + perm32(R & 31)) : R;
        voffA[i] = (unsigned)(R * K + C) * 2u; voffB[i] = (unsigned)(Rb * K + C) * 2u; }
    const size_t kstep = (size_t)(BK * 2);
    const size_t hstep = (size_t)HALF * K * 2;
    const size_t tstep = 2 * hstep;
    const unsigned ldsw = (unsigned)wid * 1024u;
    const int aoff = lds_byte(wr * 64 + fr, fq * 8), boff = lds_byte(wc * 32 + fr, fq * 8);
#define PG8_SA(b, h) (((b) * 2 + (h)) * HTB)
#define PG8_SB(b, h) ((4 + (b) * 2 + (h)) * HTB)
#define PG8_STAGE(bufoff, gbase, voff) do { _Pragma("unroll") for (int _i = 0; _i < 2; ++_i) \
        __builtin_amdgcn_global_load_lds((const unsigned*)((const char*)(gbase) + (voff)[_i]), (PG8_LAS unsigned*)(lds + (bufoff) + ldsw + _i * 8192), 16, 0, 0); } while (0)
#define PG8_LDA(dst, b, h) do { _Pragma("unroll") for (int m = 0; m < 4; ++m) _Pragma("unroll") for (int k = 0; k < 2; ++k) dst[m][k] = *(const PG8_LAS bf16x8*)(lds + PG8_SA(b, h) + aoff + m * 2048 + k * 1024); } while (0)
#define PG8_LDB(dst, b, h) do { _Pragma("unroll") for (int n = 0; n < 2; ++n) _Pragma("unroll") for (int k = 0; k < 2; ++k) dst[n][k] = *(const PG8_LAS bf16x8*)(lds + PG8_SB(b, h) + boff + n * 2048 + k * 1024); } while (0)
#define PG8_MMA(ai, bj, At, Bt) do { __builtin_amdgcn_s_setprio(1); _Pragma("unroll") for (int m = 0; m < 4; ++m) _Pragma("unroll") for (int n = 0; n < 2; ++n) _Pragma("unroll") for (int k = 0; k < 2; ++k) \
        acc[ai][bj][m][n] = __builtin_amdgcn_mfma_f32_16x16x32_bf16(Bt[n][k], At[m][k], acc[ai][bj][m][n], 0, 0, 0); __builtin_amdgcn_s_setprio(0); } while (0)
#define PG8_WAIT_V(n) asm volatile("s_waitcnt vmcnt(" #n ")" ::: "memory")
#define PG8_WAIT_L(n) asm volatile("s_waitcnt lgkmcnt(" #n ")" ::: "memory")
#define PG8_BAR __builtin_amdgcn_s_barrier()
#define PG8_SCHED __builtin_amdgcn_sched_barrier(0)
    Unit cur, nxt; int ui = 0;
    if (!S.next(0, cur)) return;
    f32x4 acc[2][2][4][2];
#pragma unroll
    for (int a = 0; a < 2; ++a)
#pragma unroll
        for (int b = 0; b < 2; ++b)
#pragma unroll
            for (int m = 0; m < 4; ++m)
#pragma unroll
                for (int n = 0; n < 2; ++n) acc[a][b][m][n] = (f32x4){0.f, 0.f, 0.f, 0.f};
    bf16x8 At[4][2], B0[2][2], B1[2][2];
    const char* cA = (const char*)g.A + (size_t)cur.pm * tstep; const char* cB = (const char*)g.Bt + (size_t)cur.pn * tstep;
    S.a_ready(cur);
    if constexpr (SP2) {
        PG8_STAGE(PG8_SB(0, 0), cB, voffB); PG8_STAGE(PG8_SB(0, 1), cB + hstep, voffB); PG8_STAGE(PG8_SA(0, 0), cA, voffA); PG8_STAGE(PG8_SA(0, 1), cA + hstep, voffA);
        if (wr == 1) PG8_BAR;
        PG8_WAIT_V(2); PG8_BAR;
        PG8_STAGE(PG8_SB(1, 0), cB + kstep, voffB); PG8_STAGE(PG8_SA(1, 0), cA + kstep, voffA); PG8_STAGE(PG8_SB(1, 1), cB + hstep + kstep, voffB);
        PG8_WAIT_V(6); PG8_BAR;
    } else {
        PG8_STAGE(PG8_SB(0, 0), cB, voffB); PG8_STAGE(PG8_SA(0, 0), cA, voffA); PG8_STAGE(PG8_SB(0, 1), cB + hstep, voffB); PG8_STAGE(PG8_SA(0, 1), cA + hstep, voffA);
        if (wr == 1) PG8_BAR;
        PG8_WAIT_V(4); PG8_BAR;
        PG8_STAGE(PG8_SB(1, 0), cB + kstep, voffB); PG8_STAGE(PG8_SA(1, 0), cA + kstep, voffA); PG8_STAGE(PG8_SB(1, 1), cB + hstep + kstep, voffB);
        PG8_WAIT_V(6); PG8_BAR;
    }
    for (;;) {
        const bool has_next = S.next(ui + 1, nxt);
        const char* nA = has_next ? (const char*)g.A + (size_t)nxt.pm * tstep : cA; const char* nB = has_next ? (const char*)g.Bt + (size_t)nxt.pn * tstep : cB;
        for (int t = 0; t < nt; t += 2) {
            const bool last = (t == nt - 2);
            const char* a1 = cA + (size_t)(t + 1) * kstep;
            const char* a2 = last ? nA : cA + (size_t)(t + 2) * kstep; const char* b2 = last ? nB : cB + (size_t)(t + 2) * kstep;
            const char* a3 = a2 + kstep; const char* b3 = b2 + kstep;
            if (last && has_next) S.a_ready(nxt);
            if constexpr (SP2) {
            PG8_LDB(B0, 0, 0); PG8_LDB(B1, 0, 1); PG8_SCHED; PG8_LDA(At, 0, 0); PG8_STAGE(PG8_SA(1, 1), a1 + hstep, voffA);
            PG8_WAIT_V(8); PG8_WAIT_L(0); PG8_BAR; PG8_MMA(0, 0, At, B0); PG8_MMA(0, 1, At, B1); PG8_BAR; PG8_SCHED;
            PG8_LDA(At, 0, 1); PG8_STAGE(PG8_SB(0, 0), b2, voffB); PG8_STAGE(PG8_SB(0, 1), b2 + hstep, voffB); PG8_STAGE(PG8_SA(0, 0), a2, voffA);
            PG8_WAIT_V(8); PG8_WAIT_L(0); PG8_BAR; PG8_MMA(1, 0, At, B0); PG8_MMA(1, 1, At, B1); PG8_BAR; PG8_SCHED;
            PG8_LDB(B0, 1, 0); PG8_LDB(B1, 1, 1); PG8_SCHED; PG8_LDA(At, 1, 0); PG8_STAGE(PG8_SA(0, 1), a2 + hstep, voffA);
            PG8_WAIT_V(8); PG8_WAIT_L(0); PG8_BAR; PG8_MMA(0, 0, At, B0); PG8_MMA(0, 1, At, B1); PG8_BAR; PG8_SCHED;
            PG8_LDA(At, 1, 1); PG8_STAGE(PG8_SB(1, 0), b3, voffB); PG8_STAGE(PG8_SB(1, 1), b3 + hstep, voffB); PG8_STAGE(PG8_SA(1, 0), a3, voffA);
            PG8_WAIT_V(8); PG8_WAIT_L(0); PG8_BAR; PG8_MMA(1, 0, At, B0); PG8_MMA(1, 1, At, B1); PG8_BAR; PG8_SCHED;
            } else {
            PG8_LDB(B0, 0, 0); PG8_SCHED; PG8_LDA(At, 0, 0); PG8_STAGE(PG8_SA(1, 1), a1 + hstep, voffA);
            PG8_WAIT_L(8); PG8_BAR; PG8_WAIT_L(0); PG8_MMA(0, 0, At, B0); PG8_BAR; PG8_SCHED;
            PG8_LDB(B1, 0, 1); PG8_STAGE(PG8_SB(0, 0), b2, voffB);
            PG8_BAR; PG8_WAIT_L(0); PG8_MMA(0, 1, At, B1); PG8_BAR;
            PG8_LDA(At, 0, 1); PG8_STAGE(PG8_SA(0, 0), a2, voffA);
            PG8_BAR; PG8_WAIT_L(0); PG8_MMA(1, 0, At, B0); PG8_BAR; PG8_SCHED;
            PG8_STAGE(PG8_SB(0, 1), b2 + hstep, voffB);
            PG8_WAIT_V(6); PG8_BAR; PG8_MMA(1, 1, At, B1); PG8_BAR;
            PG8_LDB(B0, 1, 0); PG8_SCHED; PG8_LDA(At, 1, 0); PG8_STAGE(PG8_SA(0, 1), a2 + hstep, voffA);
            PG8_WAIT_L(8); PG8_BAR; PG8_WAIT_L(0); PG8_MMA(0, 0, At, B0); PG8_BAR; PG8_SCHED;
            PG8_LDB(B1, 1, 1); PG8_STAGE(PG8_SB(1, 0), b3, voffB);
            PG8_BAR; PG8_WAIT_L(0); PG8_MMA(0, 1, At, B1); PG8_BAR;
            PG8_LDA(At, 1, 1); PG8_STAGE(PG8_SA(1, 0), a3, voffA);
            PG8_BAR; PG8_WAIT_L(0); PG8_MMA(1, 0, At, B0); PG8_BAR; PG8_SCHED;
            PG8_STAGE(PG8_SB(1, 1), b3 + hstep, voffB);
            PG8_WAIT_V(6); PG8_BAR; PG8_MMA(1, 1, At, B1); PG8_BAR;
            }
        }
        if constexpr (ALIGN_EPI) { if (wr == 0) PG8_BAR; }
        if constexpr (!Epi::AFTER_DRAIN) { E(acc, cur, wr, wc, fr, fq); S.done(cur); }
        if (!has_next) break;
#pragma unroll
        for (int a = 0; a < 2; ++a)
#pragma unroll
            for (int b = 0; b < 2; ++b)
#pragma unroll
                for (int m = 0; m < 4; ++m)
#pragma unroll
                    for (int n = 0; n < 2; ++n) acc[a][b][m][n] = (f32x4){0.f, 0.f, 0.f, 0.f};
        cur = nxt; cA = nA; cB = nB; ++ui;
        if constexpr (ALIGN_EPI) { if (wr == 1) PG8_BAR; }
    }
    PG8_WAIT_V(0);
    if constexpr (!ALIGN_EPI) { if (wr == 0) PG8_BAR; }
    PG8_BAR;
    if constexpr (Epi::AFTER_DRAIN) { E.fused(acc, cur, wr, wc, fr, fq, lds, wid, lane); S.done(cur); }
#undef PG8_SA
#undef PG8_SB
#undef PG8_STAGE
#undef PG8_LDA
#undef PG8_LDB
#undef PG8_MMA
#undef PG8_WAIT_V
#undef PG8_WAIT_L
#undef PG8_BAR
#undef PG8_SCHED
}
}

#ifndef PG8_SP2
#define PG8_SP2 true
#endif
#ifndef PG8_ALIGN
#define PG8_ALIGN true
#endif
#include <hip/hip_bf16.h>
#include <cmath>
namespace attn_body {
using bf16=__hip_bfloat16;
using bf16x8=__attribute__((ext_vector_type(8)))short;
using s16x4=__attribute__((ext_vector_type(4)))short;
using f32x16=__attribute__((ext_vector_type(16)))float;
using u32x4=__attribute__((ext_vector_type(4)))unsigned;
constexpr int SEQ=4096,D=64;
constexpr int NW=8,QBLK=32,QB=QBLK*NW,KVBLK=64,NQB=SEQ/QB;
constexpr int ATTN_UNIT_ROWS=QB;
__device__ __forceinline__ int crow(int r,int hi){return (r&3)+8*(r>>2)+4*hi;}
#define SBAR() __builtin_amdgcn_sched_barrier(0)
constexpr int NSLOT=3, SLOTB=8192;
constexpr int LDS_K=0, LDS_V=NSLOT*SLOTB, LDS_WS=2*NSLOT*SLOTB, LDS_OST=LDS_WS+NW*64*4, LDS_BYTES=LDS_OST+NW*4096;
constexpr int LDS_GST=LDS_BYTES;
constexpr float C2=0.125f*1.4426950408889634f;
__device__ __forceinline__ void glds16(const void*gsrc,unsigned lds_dst){unsigned keep;
  asm volatile("s_mov_b32 %0, m0\n\ts_mov_b32 m0, %2\n\ts_nop 0\n\tglobal_load_lds_dwordx4 %1, off\n\ts_mov_b32 m0, %0":"=&s"(keep):"v"(gsrc),"s"(lds_dst):"memory");}
__device__ __forceinline__ float max3f(float a,float b,float c){float r;asm("v_max3_f32 %0, %1, %2, %3":"=v"(r):"v"(a),"v"(b),"v"(c));return r;}
__device__ __forceinline__ float max2f(float a,float b){float r;asm("v_max_f32_e32 %0, %1, %2":"=v"(r):"v"(a),"v"(b));return r;}
__device__ __forceinline__ float fadd_s(float a,float b){float r;asm("v_add_f32_e32 %0, %1, %2":"=v"(r):"v"(a),"v"(b));return r;}
__device__ __forceinline__ float fsub_s(float a,float b){float r;asm("v_sub_f32_e32 %0, %1, %2":"=v"(r):"v"(a),"v"(b));return r;}
typedef float f32x2_t __attribute__((ext_vector_type(2))); typedef __bf16 bf16x2_t __attribute__((ext_vector_type(2)));
__device__ __forceinline__ unsigned cvtpk_s(float lo,float hi){f32x2_t v={lo,hi};bf16x2_t b=__builtin_convertvector(v,bf16x2_t);return __builtin_bit_cast(unsigned,b);}
#define WAIT_BAR(N) asm volatile("s_waitcnt vmcnt(" #N ") lgkmcnt(0)\n\ts_barrier":::"memory")

template<int ND0> __device__ __forceinline__ void qkt(f32x16&p0,f32x16&p1,const char*Kslot,const bf16x8*qr,const f32x16&negm,int r32,int hi){
  const char*kb=Kslot+hi*1024+r32*16;
  #pragma unroll
  for(int d0=0;d0<ND0;++d0){
    const bf16x8 b0=*reinterpret_cast<const bf16x8*>(kb+d0*2048);
    const bf16x8 b1=*reinterpret_cast<const bf16x8*>(kb+d0*2048+512);
    if(d0==0){p0=__builtin_amdgcn_mfma_f32_32x32x16_bf16(b0,qr[0],negm,0,0,0);p1=__builtin_amdgcn_mfma_f32_32x32x16_bf16(b1,qr[0],negm,0,0,0);}
    else{p0=__builtin_amdgcn_mfma_f32_32x32x16_bf16(b0,qr[d0],p0,0,0,0);p1=__builtin_amdgcn_mfma_f32_32x32x16_bf16(b1,qr[d0],p1,0,0,0);}}
}
typedef __attribute__((address_space(3))) const char* lds_cptr;
typedef short v4i16_t __attribute__((ext_vector_type(4)));
__device__ __forceinline__ void kload8(bf16x8*kf,lds_cptr kp){
  kf[0]=*(const __attribute__((address_space(3))) bf16x8*)(kp);      kf[1]=*(const __attribute__((address_space(3))) bf16x8*)(kp+512);
  kf[2]=*(const __attribute__((address_space(3))) bf16x8*)(kp+2048); kf[3]=*(const __attribute__((address_space(3))) bf16x8*)(kp+2560);
  kf[4]=*(const __attribute__((address_space(3))) bf16x8*)(kp+4096); kf[5]=*(const __attribute__((address_space(3))) bf16x8*)(kp+4608);
  kf[6]=*(const __attribute__((address_space(3))) bf16x8*)(kp+6144); kf[7]=*(const __attribute__((address_space(3))) bf16x8*)(kp+6656);
}
__device__ __forceinline__ void kload2(bf16x8*kf,lds_cptr kp,int j){ kf[2*j]=*(const __attribute__((address_space(3))) bf16x8*)(kp+j*2048); kf[2*j+1]=*(const __attribute__((address_space(3))) bf16x8*)(kp+j*2048+512); }
__device__ __forceinline__ s16x4 vtr(lds_cptr p){ return __builtin_bit_cast(s16x4,__builtin_amdgcn_ds_read_tr16_b64_v4i16((__attribute__((address_space(3))) v4i16_t*)p)); }
__device__ __forceinline__ float rowmax(const f32x16&p0,const f32x16&p1){
  float a=max3f(p0[0],p0[1],p1[0]),b=max3f(p0[2],p0[3],p1[1]);a=max3f(a,p1[2],p1[3]);
  #pragma unroll
  for(int r=4;r<16;r+=4){a=max3f(a,p0[r],p0[r+1]);b=max3f(b,p0[r+2],p0[r+3]);a=max3f(a,p1[r],p1[r+1]);b=max3f(b,p1[r+2],p1[r+3]);}
  const float m=max2f(a,b);
  auto rr=__builtin_amdgcn_permlane32_swap(__float_as_uint(m),__float_as_uint(m),false,false);
  return max2f(__uint_as_float(rr[0]),__uint_as_float(rr[1]));
}
__device__ __forceinline__ void pv(f32x16*o,int vb,bf16x8 pa0,bf16x8 pa1,bf16x8 pa2,bf16x8 pa3){
  #pragma unroll
  for(int d0=0;d0<2;++d0){s16x4 lo[4],hi[4];
    #pragma unroll
    for(int ks=0;ks<4;++ks){
      asm volatile("ds_read_b64_tr_b16 %0,%1 offset:%c2":"=&v"(lo[ks]):"v"(vb),"i"(d0*4096+ks*1024):"memory");
      asm volatile("ds_read_b64_tr_b16 %0,%1 offset:%c2":"=&v"(hi[ks]):"v"(vb),"i"(d0*4096+ks*1024+512):"memory");}
    asm volatile("s_waitcnt lgkmcnt(0)":::"memory");SBAR();
    #define PK(k) (bf16x8){lo[k][0],lo[k][1],lo[k][2],lo[k][3],hi[k][0],hi[k][1],hi[k][2],hi[k][3]}
    o[d0]=__builtin_amdgcn_mfma_f32_32x32x16_bf16(pa0,PK(0),o[d0],0,0,0);
    o[d0]=__builtin_amdgcn_mfma_f32_32x32x16_bf16(pa1,PK(1),o[d0],0,0,0);
    o[d0]=__builtin_amdgcn_mfma_f32_32x32x16_bf16(pa2,PK(2),o[d0],0,0,0);
    o[d0]=__builtin_amdgcn_mfma_f32_32x32x16_bf16(pa3,PK(3),o[d0],0,0,0);
    #undef PK
  }
}

#ifndef ATTN_STORE16
#define ATTN_STORE16(p,v) (*(u32x4*)(p)=(v))
#endif
template<int THRL,bool FIXREF,bool HALFK> __device__ __forceinline__ void attn_unit(float mref,long rowbase,int q0,const bf16*Qh,int PQ,const bf16*__restrict__ Kh_,int PK,const bf16*__restrict__ Vh_,int PV,bf16*Oh,int PO,const bf16*Gh,int PG,u32x4(&okeep)[4],int omode,float lam,float oml,const float*subln,char*shm){
  const int tid=fresh_tid(),lane=tid&63,r32=lane&31,hi=lane>>5; const int wid=__builtin_amdgcn_readfirstlane(tid>>6);
  const bf16*Qw=Qh+(rowbase+q0+wid*QBLK)*PQ;
  const bf16*Kh=Kh_+rowbase*PK,*Vh=Vh_+rowbase*PV;
  const unsigned lds0=(unsigned)(uintptr_t)shm;
  float*wsf=(float*)(shm+LDS_WS)+wid*64;
  const bf16*ksrc=Kh+(long)lane*PK+wid*8;
  const bf16*vsrc=Vh+(long)(16*(wid&3)+(lane>>2))*PV+(wid>>2)*32+(lane&3)*8;
  const unsigned kdst=lds0+LDS_K+wid*1024, vdst=lds0+LDS_V+wid*1024;
  #define DMA_K(t,slot) glds16(ksrc+(long)(t)*KVBLK*PK,(unsigned)__builtin_amdgcn_readfirstlane(kdst+(slot)))
  #define DMA_V(t,slot) glds16(vsrc+(long)(t)*KVBLK*PV,(unsigned)__builtin_amdgcn_readfirstlane(vdst+(slot)))
  const int vb0=(int)(lds0+LDS_V)+((lane>>4)&1)*32+(lane&3)*8+(4*hi+((lane&15)>>2))*64;
  const char*Kbase=shm+LDS_K; bf16x8 kf[8];
  const lds_cptr shm3=(lds_cptr)shm; const lds_cptr kp0=shm3+LDS_K+hi*1024+r32*16; const lds_cptr vp0=shm3+LDS_V+((lane>>4)&1)*32+(lane&3)*8+(4*hi+((lane&15)>>2))*64;
  constexpr int NT=SEQ/KVBLK;
  if(Gh){ const bf16*Gw=Gh+(rowbase+q0+wid*QBLK)*PG;
    #pragma unroll
    for(int i=0;i<4;++i) glds16(Gw+(long)(i*8+(lane>>3))*PG+(lane&7)*8,(unsigned)__builtin_amdgcn_readfirstlane(lds0+LDS_GST+wid*4096+i*1024)); }
  DMA_K(0,0);DMA_V(0,0);DMA_K(1,SLOTB);
  bf16x8 qr[4];
  #pragma unroll
  for(int d0=0;d0<4;++d0)qr[d0]=*reinterpret_cast<const bf16x8*>(&Qw[(long)r32*PQ+d0*16+hi*8]);
  float mhat=0.f,l_reg=0.f;f32x16 o[2];o[0]=f32x16{};o[1]=f32x16{};f32x16 negm=f32x16{};
  if constexpr(FIXREF){ mhat=mref; _Pragma("unroll") for(int r=0;r<16;++r)negm[r]=-mref; }
  asm volatile("":"+v"(negm));
  #define CMASK(P0,P1,t) do{}while(0)
  bool resc=false;
  #define START(P0,P1) do{ resc=false; \
    if constexpr(!FIXREF){ const float rm=rowmax(P0,P1); const float dl=rm; mhat=fadd_s(mhat,dl); \
      _Pragma("unroll") for(int r=0;r<16;++r){P0[r]=fsub_s(P0[r],dl);P1[r]=fsub_s(P1[r],dl);} \
      _Pragma("unroll") for(int r=0;r<16;++r)negm[r]=-mhat; asm volatile("":"+v"(negm)); } \
    _Pragma("unroll") for(int r=0;r<16;++r)P0[r]=__builtin_amdgcn_exp2f(P0[r]); }while(0)
  #define RESC() do{ if(!FIXREF&&resc){ asm volatile("s_waitcnt lgkmcnt(0)":::"memory"); \
      _Pragma("unroll") for(int d_=0;d_<2;++d_) _Pragma("unroll") for(int r=0;r<16;++r)o[d_][r]*=wsf[crow(r,hi)]; } }while(0)
  f32x16 pA0,pA1,pB0,pB1;
  int sl_prev=0,sl_cur=0,sl_next=SLOTB;
  #define ROT() do{sl_prev=sl_cur;sl_cur=sl_next;sl_next=(sl_next==(NSLOT-1)*SLOTB)?0:sl_next+SLOTB;}while(0)
  DMA_K(2,2*SLOTB);
  WAIT_BAR(3);
  qkt<HALFK?2:4>(pA0,pA1,Kbase,qr,negm,r32,hi);asm volatile("s_nop 15\n\ts_nop 7":"+v"(pA0),"+v"(pA1));CMASK(pA0,pA1,0);
  START(pA0,pA1);
  _Pragma("unroll") for(int r=0;r<16;++r)pA1[r]=__builtin_amdgcn_exp2f(pA1[r]);
  WAIT_BAR(0);
  DMA_K(3,0);DMA_V(1,SLOTB);
  ROT();
  if constexpr(HALFK){ kload2(kf,kp0+sl_cur,0); kload2(kf,kp0+sl_cur,1); } else kload8(kf,kp0+sl_cur);
  WAIT_BAR(2);
  s16x4 vlo[8],vhi[8]; u32x4 pw0,pw1,pw2,pw3;
  #define PKW(P,B) cvtpk_s(P[B],P[B+1])
  #define PAF(k) __builtin_bit_cast(bf16x8,pw##k)
  #define VFR(i) (bf16x8){vlo[i][0],vlo[i][1],vlo[i][2],vlo[i][3],vhi[i][0],vhi[i][1],vhi[i][2],vhi[i][3]}
  #define PIN(x) asm volatile("":"+v"(x))
  #define MX3(a,b,c) __builtin_fmaxf(__builtin_fmaxf((a),(b)),(c))
  #define GAPA(MF,A0,A1,A2,A3,W0,W1,PW) do{ MF; sacc+=A0; sacc+=A1; sacc+=A2; sacc+=A3; PIN(sacc); W0; W1; PIN(PW); SBAR(); }while(0)
  #define EX(v) __builtin_amdgcn_exp2f(v)
  #define GAPB(MF,X,B) do{ MF; X[B]=EX(X[B]); X[B+1]=EX(X[B+1]); X[B+2]=EX(X[B+2]); X[B+3]=EX(X[B+3]); PIN(X); SBAR(); }while(0)
  #define VRD(i) do{ vlo[i]=vtr(vp_+(((i)>>2)*4096+((i)&3)*1024)); vhi[i]=vtr(vp_+(((i)>>2)*4096+((i)&3)*1024+512)); }while(0)
  #define KRD(G,j) do{ if(G){ kload2(kf,kp0+sl_next,j); SBAR(); } }while(0)
  #define STEP(C0,C1,P0,P1,t,GK,GV,GL) do{ SBAR(); \
    const lds_cptr vp_=vp0+sl_prev; \
    VRD(0); SBAR(); float sacc=(P0[0]+P0[1]); \
    GAPA(C0=__builtin_amdgcn_mfma_f32_32x32x16_bf16(kf[0],qr[0],negm,0,0,0), P0[2],P0[3],P0[4],P0[5],     pw0[0]=PKW(P0,0), pw0[1]=PKW(P0,2), pw0); \
    VRD(4); SBAR(); GAPA(C1=__builtin_amdgcn_mfma_f32_32x32x16_bf16(kf[1],qr[0],negm,0,0,0), P0[6],P0[7],P0[8],P0[9],     pw0[2]=PKW(P0,4), pw0[3]=PKW(P0,6), pw0); \
    VRD(1); SBAR(); GAPA(C0=__builtin_amdgcn_mfma_f32_32x32x16_bf16(kf[2],qr[1],C0,0,0,0),   P0[10],P0[11],P0[12],P0[13], pw1[0]=PKW(P0,8), pw1[1]=PKW(P0,10), pw1); \
    VRD(5); SBAR(); GAPA(C1=__builtin_amdgcn_mfma_f32_32x32x16_bf16(kf[3],qr[1],C1,0,0,0),   P0[14],P0[15],P1[0],P1[1],   pw1[2]=PKW(P0,12),pw1[3]=PKW(P0,14), pw1); \
    VRD(2); SBAR(); GAPA(if constexpr(!HALFK) C0=__builtin_amdgcn_mfma_f32_32x32x16_bf16(kf[4],qr[2],C0,0,0,0),   P1[2],P1[3],P1[4],P1[5],     pw2[0]=PKW(P1,0), pw2[1]=PKW(P1,2), pw2); \
    VRD(6); SBAR(); GAPA(if constexpr(!HALFK) C1=__builtin_amdgcn_mfma_f32_32x32x16_bf16(kf[5],qr[2],C1,0,0,0),   P1[6],P1[7],P1[8],P1[9],     pw2[2]=PKW(P1,4), pw2[3]=PKW(P1,6), pw2); \
    VRD(3); SBAR(); GAPA(if constexpr(!HALFK) C0=__builtin_amdgcn_mfma_f32_32x32x16_bf16(kf[6],qr[3],C0,0,0,0),   P1[10],P1[11],P1[12],P1[13], pw3[0]=PKW(P1,8), pw3[1]=PKW(P1,10), pw3); \
    VRD(7); SBAR(); GAPA(if constexpr(!HALFK) C1=__builtin_amdgcn_mfma_f32_32x32x16_bf16(kf[7],qr[3],C1,0,0,0),   P1[14],P1[15],0.f,0.f,       pw3[2]=PKW(P1,12),pw3[3]=PKW(P1,14), pw3); \
    l_reg+=sacc; \
    if(GK){DMA_K((t)+3,sl_cur);} if(GV){DMA_V((t)+1,sl_next);} \
    CMASK(C0,C1,t); \
    if constexpr(!FIXREF){ float a=MX3(C0[0],C0[1],C1[0]),b=MX3(C0[2],C0[3],C1[1]); a=MX3(a,C1[2],C1[3]); \
      _Pragma("unroll") for(int r=4;r<16;r+=4){a=MX3(a,C0[r],C0[r+1]);b=MX3(b,C0[r+2],C0[r+3]);a=MX3(a,C1[r],C1[r+1]);b=MX3(b,C1[r+2],C1[r+3]);} \
      float rm=__builtin_fmaxf(a,b); { auto rr=__builtin_amdgcn_permlane32_swap(__float_as_uint(rm),__float_as_uint(rm),false,false); rm=__builtin_fmaxf(__uint_as_float(rr[0]),__uint_as_float(rr[1])); } \
      resc=false; \
      if(__builtin_expect(__any(rm>(float)THRL),0)){ const float dl=__builtin_fmaxf(rm,0.f); mhat+=dl; \
        _Pragma("unroll") for(int r=0;r<16;++r){C0[r]-=dl;C1[r]-=dl;} \
        _Pragma("unroll") for(int r=0;r<16;++r)negm[r]=-mhat; asm volatile("":"+v"(negm)); \
        const float f=__builtin_amdgcn_exp2f(-dl); l_reg*=f; if(hi==0)wsf[r32]=f; resc=true; } } \
    SBAR(); \
    GAPB(o[0]=__builtin_amdgcn_mfma_f32_32x32x16_bf16(PAF(0),VFR(0),o[0],0,0,0), C0,0); \
    GAPB(o[1]=__builtin_amdgcn_mfma_f32_32x32x16_bf16(PAF(0),VFR(4),o[1],0,0,0), C0,4); \
    KRD(GL,0); GAPB(o[0]=__builtin_amdgcn_mfma_f32_32x32x16_bf16(PAF(1),VFR(1),o[0],0,0,0), C0,8); \
    KRD(GL,1); GAPB(o[1]=__builtin_amdgcn_mfma_f32_32x32x16_bf16(PAF(1),VFR(5),o[1],0,0,0), C0,12); \
    KRD((GL)&&!HALFK,2); GAPB(o[0]=__builtin_amdgcn_mfma_f32_32x32x16_bf16(PAF(2),VFR(2),o[0],0,0,0), C1,0); \
    KRD((GL)&&!HALFK,3); GAPB(o[1]=__builtin_amdgcn_mfma_f32_32x32x16_bf16(PAF(2),VFR(6),o[1],0,0,0), C1,4); \
    GAPB(o[0]=__builtin_amdgcn_mfma_f32_32x32x16_bf16(PAF(3),VFR(3),o[0],0,0,0), C1,8); \
    GAPB(o[1]=__builtin_amdgcn_mfma_f32_32x32x16_bf16(PAF(3),VFR(7),o[1],0,0,0), C1,12); \
    }while(0)
  int t=1;
  #undef CMASK
  #define CMASK(P0,P1,t) do{}while(0)
  for(;t+5<NT;t+=2){
    STEP(pB0,pB1,pA0,pA1,t,true,true,true);     WAIT_BAR(2); RESC(); ROT();
    STEP(pA0,pA1,pB0,pB1,t+1,true,true,true);   WAIT_BAR(2); RESC(); ROT();
  }
  #undef CMASK
  #define CMASK(P0,P1,t) do{}while(0)
  #define ENDW(tt) do{ if((tt)+3<NT){WAIT_BAR(2);} else if((tt)+2<NT){WAIT_BAR(1);} else {WAIT_BAR(0);} }while(0)
  for(;t+1<NT;t+=2){
    STEP(pB0,pB1,pA0,pA1,t,(t+3<NT),(t+1<NT),(t+1<NT));       ENDW(t);   RESC(); ROT();
    STEP(pA0,pA1,pB0,pB1,t+1,(t+4<NT),(t+2<NT),(t+2<NT));     ENDW(t+1); RESC(); ROT();
  }
  STEP(pB0,pB1,pA0,pA1,NT-1,false,false,false); RESC();
  { float sacc=pB0[0]+pB0[1]; _Pragma("unroll") for(int r=2;r<16;++r)sacc+=pB0[r]; _Pragma("unroll") for(int r=0;r<16;++r)sacc+=pB1[r]; l_reg+=sacc;
    pw0=(u32x4){PKW(pB0,0),PKW(pB0,2),PKW(pB0,4),PKW(pB0,6)};pw1=(u32x4){PKW(pB0,8),PKW(pB0,10),PKW(pB0,12),PKW(pB0,14)};pw2=(u32x4){PKW(pB1,0),PKW(pB1,2),PKW(pB1,4),PKW(pB1,6)};pw3=(u32x4){PKW(pB1,8),PKW(pB1,10),PKW(pB1,12),PKW(pB1,14)};
    SBAR(); pv(o,vb0+sl_cur,PAF(0),PAF(1),PAF(2),PAF(3)); }
  #undef PKW
  #undef PAF
  #undef VFR
  #undef PIN
  #undef MX3
  #undef GAPA
  #undef GAPB
  #undef EX
  #undef VRD
  #undef KRD
  #undef STEP
  #undef ENDW
  {auto rr=__builtin_amdgcn_permlane32_swap(__float_as_uint(l_reg),__float_as_uint(l_reg),false,false);l_reg=__uint_as_float(rr[0])+__uint_as_float(rr[1]);}
  if(hi==0)wsf[32+r32]=l_reg;asm volatile("s_waitcnt lgkmcnt(0)":::"memory");
  float rli[16];
  #pragma unroll
  for(int r=0;r<16;++r)rli[r]=__builtin_amdgcn_rcpf(wsf[32+crow(r,hi)]);
  bf16*Ow=Oh+(rowbase+q0+wid*QBLK)*PO;
  { bf16*stg=(bf16*)(shm+LDS_OST)+wid*2048;
    #pragma unroll
    for(int r=0;r<16;++r){const int orow=crow(r,hi);
      #pragma unroll
      for(int d0=0;d0<2;++d0)stg[orow*64+d0*32+r32]=__float2bfloat16(o[d0][r]*rli[r]);}
    asm volatile("s_waitcnt lgkmcnt(0)":::"memory");
    if(omode==2){
      u32x4 gv[4]; const char*gst=shm+LDS_GST+wid*4096+lane*16;
      #pragma unroll
      for(int i=0;i<4;++i) gv[i]=*(const u32x4*)(gst+i*1024);
      float sg[8]; { const int ch=lane&7;
        #pragma unroll
        for(int e=0;e<8;++e)sg[e]=subln[ch*8+e]*oml; }
      #pragma unroll
      for(int i=0;i<4;++i){const int row=i*8+(lane>>3),ch=lane&7; u32x4 v=*(const u32x4*)(stg+row*64+ch*8); float d[8]; float ss=0.f;
        #pragma unroll
        for(int k=0;k<4;++k){ d[2*k]=__uint_as_float(okeep[i][k]<<16)-lam*__uint_as_float(v[k]<<16); d[2*k+1]=__uint_as_float(okeep[i][k]&0xffff0000u)-lam*__uint_as_float(v[k]&0xffff0000u); ss+=d[2*k]*d[2*k]+d[2*k+1]*d[2*k+1]; }
        ss+=__shfl_xor(ss,1); ss+=__shfl_xor(ss,2); ss+=__shfl_xor(ss,4);
        const float rstd=rsqrtf(ss*(1.f/64.f)+1e-6f);
        #pragma unroll
        for(int k=0;k<4;++k){ const float g0=__uint_as_float(gv[i][k]<<16),g1=__uint_as_float(gv[i][k]&0xffff0000u);
          v[k]=cvtpk_s(d[2*k]*rstd*sg[2*k]*g0*__builtin_amdgcn_rcpf(1.f+__builtin_amdgcn_exp2f(-1.4426950408889634f*g0)),d[2*k+1]*rstd*sg[2*k+1]*g1*__builtin_amdgcn_rcpf(1.f+__builtin_amdgcn_exp2f(-1.4426950408889634f*g1))); }
        ATTN_STORE16(Ow+(long)row*PO+ch*8,v);} }
    else if(Gh){
      u32x4 gv[4]; const char*gst=shm+LDS_GST+wid*4096+lane*16;
      #pragma unroll
      for(int i=0;i<4;++i) gv[i]=*(const u32x4*)(gst+i*1024);
      #pragma unroll
      for(int i=0;i<4;++i){const int row=i*8+(lane>>3),ch=lane&7; u32x4 v=*(const u32x4*)(stg+row*64+ch*8);
        #pragma unroll
        for(int k=0;k<4;++k){ const float g0=__uint_as_float(gv[i][k]<<16),g1=__uint_as_float(gv[i][k]&0xffff0000u),o0=__uint_as_float(v[k]<<16),o1=__uint_as_float(v[k]&0xffff0000u);
          v[k]=cvtpk_s(o0*g0*__builtin_amdgcn_rcpf(1.f+__builtin_amdgcn_exp2f(-1.4426950408889634f*g0)),o1*g1*__builtin_amdgcn_rcpf(1.f+__builtin_amdgcn_exp2f(-1.4426950408889634f*g1))); }
        ATTN_STORE16(Ow+(long)row*PO+ch*8,v);} }
    else if(omode==1){
    #pragma unroll
    for(int i=0;i<4;++i){const int row=i*8+(lane>>3),ch=lane&7; okeep[i]=*(const u32x4*)(stg+row*64+ch*8);} }
    else{
    #pragma unroll
    for(int i=0;i<4;++i){const int row=i*8+(lane>>3),ch=lane&7; const u32x4 v=*(const u32x4*)(stg+row*64+ch*8); ATTN_STORE16(Ow+(long)row*PO+ch*8,v);} } }
  asm volatile("s_waitcnt lgkmcnt(0)\n\ts_barrier":::"memory");
  #undef DMA_K
  #undef DMA_V
  #undef CMASK
  #undef START
  #undef RESC
  #undef ROT
}
constexpr int ATTN_LDS_BYTES=LDS_BYTES+NW*4096;
#undef SBAR
#undef WAIT_BAR
}
namespace cg = cooperative_groups;
#define GAS __attribute__((address_space(1)))
#define LAS __attribute__((address_space(3)))
typedef unsigned short bf16r;
typedef unsigned v4u __attribute__((ext_vector_type(4)));
typedef unsigned v2u __attribute__((ext_vector_type(2)));
typedef float f32x4 __attribute__((ext_vector_type(4)));
typedef float f32x16 __attribute__((ext_vector_type(16)));
typedef short bf16x8 __attribute__((ext_vector_type(8)));

constexpr int NWAVES = 8, NTHR = 512;
constexpr int BATCH = 8, SEQ = 4096, DMODEL = 1024, DIN = 3840, MROWS = BATCH * SEQ, DEPTH = 2;
constexpr float EPS = 1e-6f;
constexpr int C_AQ = 0, C_AK = 256, C_AV = 384, C_AG = 512, C_BP = 768, C_BG = 1536, C_CQ = 1792, C_CK = 2048, C_CV = 2304, C_CG = 2560, C_DP = 2816, C_DG = 3584;
constexpr size_t MiB = 1u << 20;
constexpr size_t WS_CTL = 0, CTL_ZERO_BYTES = 1 * MiB;
constexpr size_t WS_MOD = 0;
constexpr size_t WS_NORM = 256 * 1024;
constexpr size_t WS_BAR = 512 * 1024;
constexpr int MISC_OFF = 131072 + 320;
constexpr size_t WS_TABSEQ = 1 * MiB;
constexpr size_t WS_TABRC = 1 * MiB + 512 * 1024;
constexpr size_t WS_RG = 2 * MiB;
constexpr size_t WS_WIN = 10 * MiB;
constexpr size_t WS_WOUT = 25 * MiB;
constexpr size_t WS_H = 32 * MiB;
constexpr size_t WS_PROJ = 96 * MiB;
constexpr size_t WS_QA = 336 * MiB;
constexpr size_t WS_KA = 352 * MiB;
constexpr size_t WS_QC = 360 * MiB;
constexpr size_t WS_KC = 392 * MiB;
constexpr size_t WS_ZT = 424 * MiB;
constexpr size_t WS_YT = 440 * MiB;
constexpr size_t WS_OA = 456 * MiB;
constexpr size_t WS_OC = 472 * MiB;
constexpr size_t WS_DELTA = WS_QA;
constexpr size_t WS_RG1 = 504 * MiB;
constexpr size_t WS_END = 512 * MiB;
constexpr int LDS_BYTES = 147456;

struct Params { const float* in[26]; float* out; unsigned char* ws; float inv[16]; float lam_init[2]; int pad[2]; };

typedef const __attribute__((address_space(4))) Params* KParams;
__device__ __forceinline__ KParams fresh_params() { KParams kp = (KParams)__builtin_amdgcn_kernarg_segment_ptr(); asm volatile("" : "+s"(kp)); return kp; }
__device__ __forceinline__ unsigned f2bf(float f) { unsigned u = __builtin_bit_cast(unsigned, f); return (u + 0x7fffu + ((u >> 16) & 1u)) >> 16; }
__device__ __forceinline__ unsigned pk2(float lo, float hi) { return f2bf(lo) | (f2bf(hi) << 16); }
__device__ __forceinline__ float bflo(unsigned w) { return __builtin_bit_cast(float, w << 16); }
__device__ __forceinline__ float bfhi(unsigned w) { return __builtin_bit_cast(float, w & 0xffff0000u); }
__device__ __forceinline__ float bf1(bf16r h) { return __builtin_bit_cast(float, (unsigned)h << 16); }
__device__ __forceinline__ float silu_f(float v) { return v / (1.f + __expf(-v)); }
#define LDS_WAIT() asm volatile("s_waitcnt lgkmcnt(0)" ::: "memory")
__device__ __forceinline__ float shx(float v, int mask, int lane) { return __builtin_bit_cast(float, __builtin_amdgcn_ds_bpermute((lane ^ mask) << 2, __builtin_bit_cast(int, v))); }

__host__ __device__ __forceinline__ int win_l2p(int l) { return (int)((0xd951ecb8a746032ULL >> (4 * l)) & 15); }
__host__ __device__ __forceinline__ int win_p2l(int p) { return (int)((0xae986d753c410b2ULL >> (4 * p)) & 15); }
__device__ __forceinline__ int win_row_remap(int n0) {
    if (n0 < 256) { const int h = n0 >> 6, bj = (n0 >> 5) & 1; return 128 * bj + 32 * h; }
    if (n0 < 384) { const int q = n0 - 256, h = q >> 6, bj = (q >> 5) & 1; return 256 + 128 * bj + 32 * h; }
    if (n0 < 512) { const int j = n0 - 384; return j < 64 ? 256 + 64 + j : 256 + 192 + (j - 64); }
    if (n0 >= 2816) {
        const int q = n0 - 2816, a = q >> 8, cc = q & 255, h = cc >> 7, off = cc & 127;
        const int tile = (a == 0 || a == 3) ? 11 + h : 13 + h, bj = (a == 0 || a == 1) ? 0 : 1;
        return 256 * tile + 128 * bj + off; }
    return n0; }
__device__ __forceinline__ bool win_block_plain(int n0) { return !(n0 < 384 || (n0 >= 1024 && n0 < 1536) || (n0 >= 1792 && n0 < 2304)); }
template <bool REMAP> __device__ __forceinline__ void p0_transpose_item(const float* W, int K, int N, bf16r* WT, LAS float* scr, int item, int lane) {
    const int nblk = N / 32, kb = item / nblk, nb = item % nblk, k0 = 64 * kb, n0 = 32 * nb, rl = REMAP ? win_row_remap(n0) : n0, r0 = REMAP ? 256 * win_l2p(rl >> 8) + (rl & 255) : n0;
    const bool slot = REMAP && win_block_plain(n0);
#pragma unroll 8
    for (int i = 0; i < 32; ++i) { const int kk = 2 * i + (lane >> 5); scr[kk * 33 + (lane & 31)] = W[(size_t)(k0 + kk) * N + n0 + (lane & 31)]; }
    LDS_WAIT(); asm volatile("" ::: "memory");
    const int c = lane & 7;
#pragma unroll
    for (int j = 0; j < 4; ++j) { const int n = (lane >> 3) + 8 * j; const LAS float* s = scr + (8 * c) * 33 + n;
        v4u o; o.x = pk2(s[0 * 33], s[1 * 33]); o.y = pk2(s[2 * 33], s[3 * 33]); o.z = pk2(s[4 * 33], s[5 * 33]); o.w = pk2(s[6 * 33], s[7 * 33]);
        const int rn = slot ? (16 * ((n >> 2) & 1) + 4 * (n >> 3) + (n & 3)) : n;
        *(v4u*)(WT + (size_t)(r0 + rn) * K + k0 + 8 * c) = o; }
    LDS_WAIT(); asm volatile("" ::: "memory");
}

__device__ __forceinline__ void phase_prologue(LAS unsigned char* lds, int vcu, int G, bool first) {
    const int tid = fresh_tid(), lane = tid & 63, wave = __builtin_amdgcn_readfirstlane(tid >> 6);
    const KParams P = fresh_params(); unsigned char* ws = P->ws;
    {
        LAS float* scr = (LAS float*)(lds + wave * 16384);
        const int gw = vcu * NWAVES + wave, NGW = G * NWAVES;
        constexpr int I_IN = (DMODEL / 64) * (DIN / 32), I_OUT = (DMODEL / 64) * (DMODEL / 32);
        constexpr int NITEMS = DEPTH * (I_IN + I_OUT);
        for (int it = gw; it < NITEMS; it += NGW) {
            int l = it / (I_IN + I_OUT), r = it % (I_IN + I_OUT);
            if (r < I_IN) p0_transpose_item<true>(P->in[5] + (size_t)l * DMODEL * DIN, DMODEL, DIN, (bf16r*)(ws + WS_WIN) + (size_t)l * DIN * DMODEL, scr, r, lane);
            else p0_transpose_item<false>(P->in[6] + (size_t)l * DMODEL * DMODEL, DMODEL, DMODEL, (bf16r*)(ws + WS_WOUT) + (size_t)l * DMODEL * DMODEL, scr, r - I_IN, lane);
        }
    }
    __syncthreads();
    LAS float* L = (LAS float*)lds;
    for (int it = blockIdx.x; it < 192 + 256; it += G) {
        if (it < 192) {
            const int l = it / 96, r = it % 96, cb = r / 16, kc = r % 16;
            { const int b = tid >> 6, kk = tid & 63; L[b * 64 + kk] = silu_f(P->in[1][b * DMODEL + kc * 64 + kk]); }
            __syncthreads();
            const int j = cb * 512 + tid;
            const float* w = P->in[3] + (size_t)l * DMODEL * 3072 + (size_t)(kc * 64) * 3072 + j;
            float acc[8];
#pragma unroll
            for (int b = 0; b < 8; ++b) acc[b] = 0.f;
#pragma unroll 16
            for (int kk = 0; kk < 64; ++kk) { const float wv = w[(size_t)kk * 3072];
#pragma unroll
                for (int b = 0; b < 8; ++b) acc[b] += L[b * 64 + kk] * wv; }
            const float bb = (kc == 0) ? P->in[4][l * 3072 + j] : 0.f;
            float* mod = (float*)(ws + WS_MOD) + (size_t)l * 8 * 3072 + j;
#pragma unroll
            for (int b = 0; b < 8; ++b) atomicAdd(mod + b * 3072, first ? acc[b] + bb : 0.f);
            __syncthreads();
        } else {
            const int q = it - 192, l = q / 128, t0 = (q % 128) * 32;
            LAS float* emb = L;
            LAS float* h1 = L + 32 * 33;
            LAS float* h2 = h1 + 32 * 64;
            for (int idx = tid; idx < 32 * 33; idx += NTHR) {
                const int p = idx / 33, k = idx % 33; const float t = (float)(t0 + p);
                const float w = (6.2831855f * t) * (1.0f / 4096.0f);
                float v;
                if (k == 0) v = t / 4095.0f;
                else { const int i = (k - 1) & 15; const float fk = 1e-4f + (float)i * ((15.0f - 1e-4f) / 15.0f); const float a = fk * w; v = (k <= 16) ? cosf(a) : -sinf(a); }
                emb[idx] = v;
            }
            __syncthreads();
            const float* w1 = P->in[11] + l * 33 * 64; const float* b1 = P->in[12] + l * 64; const float* fr = P->in[13] + l * 64;
            const float* w2 = P->in[14] + l * 64 * 64; const float* b2 = P->in[15] + l * 64; const float* w3 = P->in[16] + l * 64 * 512;
            {
                const int j = tid & 63, pb = tid >> 6; const float frj = fr[j];
                { float wc[33];
#pragma unroll
                  for (int k = 0; k < 33; ++k) wc[k] = w1[k * 64 + j];
                  const float bj = b1[j];
#pragma unroll 1
                  for (int e = 0; e < 4; ++e) { const int p = pb + 8 * e; float v = bj;
#pragma unroll
                      for (int k = 0; k < 33; ++k) v += emb[p * 33 + k] * wc[k];
                      h1[p * 64 + j] = sinf(frj * v); } }
                __syncthreads();
                { float wc[64];
#pragma unroll
                  for (int k = 0; k < 64; ++k) wc[k] = w2[k * 64 + j];
                  const float bj = b2[j];
#pragma unroll 1
                  for (int e = 0; e < 4; ++e) { const int p = pb + 8 * e; float v = bj;
#pragma unroll
                      for (int k = 0; k < 64; ++k) v += h1[p * 64 + k] * wc[k];
                      h2[p * 64 + j] = sinf(frj * v); } }
                __syncthreads();
            }
            {
                const int ch = tid, c = ch & 255, isb = ch >> 8;
                const float absd = 3.0701134573253945f + (float)c * ((15.350567286626972f - 3.0701134573253945f) / 255.0f);
                bf16r* rg = (bf16r*)(ws + WS_RG) + ((size_t)l * 256 + c) * 8192; bf16r* rg1 = (bf16r*)(ws + WS_RG1) + ((size_t)l * 256 + c) * 8192;
                float nsum = 0.f; float w3c[64];
#pragma unroll
                for (int k = 0; k < 64; ++k) w3c[k] = w3[k * 512 + ch];
#pragma unroll 1
                for (int p = 0; p < 32; ++p) {
                    float o = 0.f;
#pragma unroll
                    for (int k = 0; k < 64; ++k) o += h2[p * 64 + k] * w3c[k];
                    const int t = t0 + p; const float tl = (float)t / 4095.0f;
                    const float v = o * (__expf(-tl * absd) + 0.05f);
                    if (!isb) { rg[4096 - t] = (bf16r)f2bf(v); rg1[4095 - t] = (bf16r)f2bf(v); nsum += fabsf(v); }
                    else if (t > 0) { rg[4096 + t] = (bf16r)f2bf(v); rg1[4095 + t] = (bf16r)f2bf(v); nsum += fabsf(v); }
                }
                if (t0 == 0 && !isb) { rg[0] = 0; rg1[8191] = 0; }
                atomicAdd((float*)(ws + WS_NORM) + l * 256 + c, first ? nsum : 0.f);
            }
            __syncthreads();
        }
    }
    {
        float2* tseq = (float2*)(ws + WS_TABSEQ); float2* trc = (float2*)(ws + WS_TABRC);
        for (int idx = blockIdx.x * NTHR + tid; idx < 4096 * 16 + 64 * 16; idx += G * NTHR) {
            const int e = idx < 65536 ? idx : idx - 65536; const int pos = e >> 4, i = e & 15;
            const float a = (float)pos * P->inv[i];
            const float2 cs = make_float2(cosf(a), sinf(a));
            if (idx < 65536) tseq[e] = cs; else trc[e] = cs;
        }
    }
}

__host__ __device__ __forceinline__ int d0_col(int c) { return c < 384 ? c : c < 896 ? c + 640 : c + 896; }
__device__ __forceinline__ void phase_norm(int l, int vcu, int G) {
    const int tid = fresh_tid(), lane = tid & 63, wave = __builtin_amdgcn_readfirstlane(tid >> 6);
    const KParams P = fresh_params(); unsigned char* ws = P->ws; bf16r* H = (bf16r*)(ws + WS_H);
    const float* xin = P->in[0]; const bf16r* DL = (const bf16r*)(ws + WS_PROJ);
    const float* g = P->in[2] + l * DMODEL; const float* mod = (const float*)(ws + WS_MOD) + (size_t)l * 8 * 3072;
    const int gw = vcu * NWAVES + wave, NGW = G * NWAVES;
    for (int m = gw; m < MROWS; m += NGW) {
        const float* xr = xin + (size_t)m * DMODEL + 8 * lane;
        f32x4 v[2][2]; float s = 0.f;
#pragma unroll
        for (int j = 0; j < 2; ++j) { v[j][0] = *(const f32x4*)(xr + 512 * j); v[j][1] = *(const f32x4*)(xr + 512 * j + 4); }
        if (l > 0) {
            const bf16r* dr = DL + (size_t)m * DIN;
#pragma unroll
            for (int j = 0; j < 2; ++j) { const v4u d = *(const v4u*)(dr + d0_col(512 * j + 8 * lane));
                v[j][0].x += bflo(d.x); v[j][0].y += bfhi(d.x); v[j][0].z += bflo(d.y); v[j][0].w += bfhi(d.y); v[j][1].x += bflo(d.z); v[j][1].y += bfhi(d.z); v[j][1].z += bflo(d.w); v[j][1].w += bfhi(d.w); }
        }
#pragma unroll
        for (int j = 0; j < 2; ++j)
#pragma unroll
            for (int h = 0; h < 2; ++h) s += (v[j][h].x * v[j][h].x + v[j][h].y * v[j][h].y) + (v[j][h].z * v[j][h].z + v[j][h].w * v[j][h].w);
#pragma unroll
        for (int o = 1; o < 64; o <<= 1) s += shx(s, o, lane);
        const float rstd = rsqrtf(s * (1.f / DMODEL) + EPS);
        const float* mb = mod + (m >> 12) * 3072;
#pragma unroll
        for (int j = 0; j < 2; ++j) { const int col = 512 * j + 8 * lane; f32x4 hh[2];
#pragma unroll
            for (int h = 0; h < 2; ++h) { const f32x4 gg = *(const f32x4*)(g + col + 4 * h), sh = *(const f32x4*)(mb + col + 4 * h), sc = *(const f32x4*)(mb + 1024 + col + 4 * h);
                hh[h] = v[j][h] * rstd * gg * (sc + 1.0f) + sh; }
            v4u o; o.x = pk2(hh[0].x, hh[0].y); o.y = pk2(hh[0].z, hh[0].w); o.z = pk2(hh[1].x, hh[1].y); o.w = pk2(hh[1].z, hh[1].w);
            *(v4u*)(H + (size_t)m * DMODEL + col) = o; }
    }
}

__device__ __forceinline__ void unpack8(const v4u w, float (&f)[8]) {
    f[0] = bflo(w.x); f[1] = bfhi(w.x); f[2] = bflo(w.y); f[3] = bfhi(w.y); f[4] = bflo(w.z); f[5] = bfhi(w.z); f[6] = bflo(w.w); f[7] = bfhi(w.w); }
__device__ __forceinline__ v4u pack8(const float (&f)[8]) { v4u o; o.x = pk2(f[0], f[1]); o.y = pk2(f[2], f[3]); o.z = pk2(f[4], f[5]); o.w = pk2(f[6], f[7]); return o; }
constexpr int YTP = 66;
template <int VPL, int HD, bool AXIAL>
__device__ __forceinline__ void qk_norm_rope(float (&v)[VPL], int lane, const float* gain, const float2* tseq_or_row, const float2* tcol, float outscale) {
    const int d0 = (lane * VPL) % HD;
    float ss = 0.f;
#pragma unroll
    for (int e = 0; e < VPL; ++e) ss += v[e] * v[e];
#pragma unroll
    for (int o = 1; o < HD / VPL; o <<= 1) ss += __shfl_xor(ss, o);
    const float rstd = rsqrtf(ss * (1.f / HD) + EPS);
    const int db = d0 & 31; const bool x2 = db >= 16; const int i0 = db & 15;
    const float2* tab = (AXIAL && (d0 & 32)) ? tcol : tseq_or_row;
#pragma unroll
    for (int e = 0; e < VPL; ++e) {
        const float y = v[e] * rstd * gain[d0 + e];
        const float pr = __shfl_xor(y, 16 / VPL);
        const float2 cs = tab[i0 + e];
        v[e] = (x2 ? (y * cs.x + pr * cs.y) : (y * cs.x - pr * cs.y)) * outscale;
    }
}

__device__ __forceinline__ void phase_prep(int l, LAS unsigned char* lds, int G) {
    const int tid = fresh_tid(), lane = tid & 63, wave = __builtin_amdgcn_readfirstlane(tid >> 6);
    const KParams P = fresh_params(); unsigned char* ws = P->ws;
    const bf16r* PROJ = (const bf16r*)(ws + WS_PROJ);
    bf16r* QA = (bf16r*)(ws + WS_QA); bf16r* KA = (bf16r*)(ws + WS_KA); bf16r* QC = (bf16r*)(ws + WS_QC); bf16r* KC = (bf16r*)(ws + WS_KC); bf16r* ZT = (bf16r*)(ws + WS_ZT);
    const float2* tseq = (const float2*)(ws + WS_TABSEQ); const float2* trc = (const float2*)(ws + WS_TABRC);
    const float* aqn = P->in[7] + l * 64; const float* akn = P->in[8] + l * 64; const float* cqn = P->in[18] + l * 32; const float* ckn = P->in[19] + l * 32;
    const float* cw = P->in[9] + l * 3 * 768; const float* cbv = P->in[10] + l * 768;
    constexpr float L2E = 1.4426950408889634f;
    LAS bf16r* zt = (LAS bf16r*)lds;
    for (int tile = blockIdx.x; tile < MROWS / 64; tile += G) {
        const int b = tile >> 6, t0 = (tile & 63) * 64; const size_t row0 = (size_t)tile * 64;
        {
            const int c8 = tid & 31, rgp = tid >> 5, c = 8 * c8, tl0 = 4 * rgp, tb = t0 + tl0;
            const bf16r* base = PROJ + (row0 + tl0) * DIN + C_BP + c;
            v4u xw[6], vw[6];
#pragma unroll
            for (int q = 0; q < 6; ++q) { const int t = tb + q - 1; const bool ok = (t >= 0) && (t < SEQ);
                v4u a = (v4u){0u, 0u, 0u, 0u}, d = a;
                if (ok) { const bf16r* pr = base + (long)(q - 1) * DIN; a = *(const v4u*)(pr + 256); d = *(const v4u*)(pr + 512); }
                xw[q] = a; vw[q] = d; }
#pragma unroll
            for (int r = 0; r < 4; ++r) { float xa[8], xb[8], xc[8], va[8], vb[8], vc[8];
                unpack8(xw[r], xa); unpack8(xw[r + 1], xb); unpack8(xw[r + 2], xc); unpack8(vw[r], va); unpack8(vw[r + 1], vb); unpack8(vw[r + 2], vc);
#pragma unroll
                for (int e = 0; e < 8; ++e) {
                    const float x1 = cw[256 + c + e] * xa[e] + cw[768 + 256 + c + e] * xb[e] + cw[1536 + 256 + c + e] * xc[e] + cbv[256 + c + e];
                    const float v1 = cw[512 + c + e] * va[e] + cw[768 + 512 + c + e] * vb[e] + cw[1536 + 512 + c + e] * vc[e] + cbv[512 + c + e];
                    zt[(c + e) * YTP + tl0 + r] = (bf16r)f2bf(x1 * v1); } }
        }
        __syncthreads();
#pragma unroll 4
        for (int i = 0; i < 16; ++i) { const int c = 32 * wave + 2 * i + (lane >> 5), tl = 2 * (lane & 31);
            const unsigned w = *(const LAS unsigned*)(zt + c * YTP + tl);
            *(unsigned*)(ZT + ((size_t)c * BATCH + b) * SEQ + t0 + tl) = w; }
        __syncthreads();
    }
}

__device__ __forceinline__ int crow_(int r, int hi) { return (r & 3) + 8 * (r >> 2) + 4 * hi; }
constexpr int RG1_LDS = 16384 + 64;
constexpr int ZPITCH = 8208;
__device__ __forceinline__ void phase_hyena(int l, LAS unsigned char* lds, int G) {
    const int tid = fresh_tid(), lane = tid & 63, wave = __builtin_amdgcn_readfirstlane(tid >> 6);
    const KParams P = fresh_params(); unsigned char* ws = P->ws;
    const bf16r* X1T = (const bf16r*)(ws + WS_ZT); const bf16r* VT = (const bf16r*)(ws + WS_OA); bf16r* YT = (bf16r*)(ws + WS_YT);
    const float* cw = P->in[9] + l * 3 * 768; const float* cbv = P->in[10] + l * 768;
    const bf16r* RG = (const bf16r*)(ws + WS_RG) + (size_t)l * 256 * 8192; const bf16r* RG1 = (const bf16r*)(ws + WS_RG1) + (size_t)l * 256 * 8192;
    const float* NORM = (const float*)(ws + WS_NORM) + l * 256; const float* hb = P->in[17] + l * 256;
    LAS unsigned char* Zs = lds; LAS bf16r* rl = (LAS bf16r*)(lds + 8 * ZPITCH);
    const int r32 = lane & 31, hi = lane >> 5;
    for (int c = blockIdx.x; c < 256; c += G) {
        {
            const float wx0 = cw[256 + c], wx1 = cw[768 + 256 + c], wx2 = cw[1536 + 256 + c], bx = cbv[256 + c];
            const float wv0 = cw[512 + c], wv1 = cw[768 + 512 + c], wv2 = cw[1536 + 512 + c], bv = cbv[512 + c];
#pragma unroll
            for (int b = 0; b < 8; ++b) { const bf16r* xr = X1T + ((size_t)c * BATCH + b) * SEQ + tid * 8; const bf16r* vr = VT + ((size_t)c * BATCH + b) * SEQ + tid * 8;
                float xf[10], vf[10]; { float t8[8]; unpack8(*(const v4u*)xr, t8);
#pragma unroll
                    for (int e = 0; e < 8; ++e) xf[e + 1] = t8[e]; unpack8(*(const v4u*)vr, t8);
#pragma unroll
                    for (int e = 0; e < 8; ++e) vf[e + 1] = t8[e]; }
                xf[0] = tid > 0 ? bf1(xr[-1]) : 0.f; vf[0] = tid > 0 ? bf1(vr[-1]) : 0.f; xf[9] = tid < NTHR - 1 ? bf1(xr[8]) : 0.f; vf[9] = tid < NTHR - 1 ? bf1(vr[8]) : 0.f;
                float z[8];
#pragma unroll
                for (int e = 0; e < 8; ++e) z[e] = (wx0 * xf[e] + wx1 * xf[e + 1] + wx2 * xf[e + 2] + bx) * (wv0 * vf[e] + wv1 * vf[e + 1] + wv2 * vf[e + 2] + bv);
                *(LAS v4u*)(Zs + b * ZPITCH + tid * 16) = pack8(z); }
        }
#pragma unroll
        for (int i = 0; i < 2; ++i) { *(LAS v4u*)((LAS unsigned char*)rl + (i * NTHR + tid) * 16) = *(const v4u*)(RG + (size_t)c * 8192 + (i * NTHR + tid) * 8);
            *(LAS v4u*)((LAS unsigned char*)rl + RG1_LDS + (i * NTHR + tid) * 16) = *(const v4u*)(RG1 + (size_t)c * 8192 + (i * NTHR + tid) * 8); }
        __syncthreads();
        const float invn = 1.0f / NORM[c], bias = hb[c];
        f32x16 acc[2][2];
#pragma unroll
        for (int a = 0; a < 2; ++a)
#pragma unroll
            for (int bb = 0; bb < 2; ++bb) acc[a][bb] = f32x16{};
        const int Dlo = (8 * wave - 63) > -63 ? (8 * wave - 63) : -63, Dhi = (8 * wave + 7) < 63 ? (8 * wave + 7) : 63;
        const LAS unsigned char* zb = Zs + (r32 & 7) * ZPITCH + hi * 16;
        const LAS unsigned char* apar = (const LAS unsigned char*)rl + (r32 & 1) * RG1_LDS;
#define HY_BODY(DO0, DO1) do { \
            bf16x8 A6[6]; \
            const LAS unsigned* ap = (const LAS unsigned*)(apar + (4096 - 64 * D - 32 + 8 * hi - r32 - (r32 & 1)) * 2);     \
            _Pragma("unroll") for (int q = 0; q < 6; ++q) { v4u w; w.x = ap[8 * q]; w.y = ap[8 * q + 1]; w.z = ap[8 * q + 2]; w.w = ap[8 * q + 3]; A6[q] = __builtin_bit_cast(bf16x8, w); } \
            bf16x8 Bf[2][4]; \
            _Pragma("unroll") for (int ct = 0; ct < 2; ++ct) { if (ct == 0 ? (DO0) : (DO1)) { const int J = 8 * wave + 4 * ct + (r32 >> 3) - D; const bool ok = (unsigned)J < 64u; \
                _Pragma("unroll") for (int ks = 0; ks < 4; ++ks) { bf16x8 z = bf16x8{}; if (ok) z = *(const LAS bf16x8*)(zb + (64 * J + 16 * ks) * 2); Bf[ct][ks] = z; } } } \
            __builtin_amdgcn_s_setprio(1); \
            _Pragma("unroll") for (int ks = 0; ks < 4; ++ks) _Pragma("unroll") for (int rt = 0; rt < 2; ++rt) _Pragma("unroll") for (int ct = 0; ct < 2; ++ct) \
                if (ct == 0 ? (DO0) : (DO1)) acc[rt][ct] = __builtin_amdgcn_mfma_f32_32x32x16_bf16(A6[ks - 2 * rt + 2], Bf[ct][ks], acc[rt][ct], 0, 0, 0); \
            __builtin_amdgcn_s_setprio(0); } while (0)
        { int D = Dlo;
          for (; D < 8 * wave - 59; ++D) HY_BODY(true, false);
          for (; D <= 8 * wave + 3; ++D) HY_BODY(true, true);
          for (; D <= Dhi; ++D) HY_BODY(false, true); }
#undef HY_BODY
        const int b = r32 & 7;
#pragma unroll
        for (int rt = 0; rt < 2; ++rt)
#pragma unroll
            for (int ct = 0; ct < 2; ++ct) { const int I = 8 * wave + 4 * ct + (r32 >> 3);
#pragma unroll
                for (int k2 = 0; k2 < 2; ++k2) { v2u pk[2];
#pragma unroll
                    for (int rr = 0; rr < 2; ++rr) { const int r4 = 2 * k2 + rr, t = 64 * I + 32 * rt + 8 * r4 + 4 * hi;
                        const v2u zz = *(const LAS v2u*)(Zs + b * ZPITCH + t * 2);
                        const float y0 = acc[rt][ct][4 * r4 + 0] * invn + bias * bflo(zz.x), y1 = acc[rt][ct][4 * r4 + 1] * invn + bias * bfhi(zz.x);
                        const float y2 = acc[rt][ct][4 * r4 + 2] * invn + bias * bflo(zz.y), y3 = acc[rt][ct][4 * r4 + 3] * invn + bias * bfhi(zz.y);
                        pk[rr].x = pk2(y0, y1); pk[rr].y = pk2(y2, y3); }
                    const auto sx = __builtin_amdgcn_permlane32_swap(pk[0].x, pk[1].x, false, false); const auto sy = __builtin_amdgcn_permlane32_swap(pk[0].y, pk[1].y, false, false);
                    v4u o; o.x = sx[0]; o.y = sy[0]; o.z = sx[1]; o.w = sy[1];
                    *(v4u*)(YT + ((size_t)c * BATCH + b) * SEQ + 64 * I + 32 * rt + 16 * k2 + 8 * hi) = o; } }
        __syncthreads();
    }
}

__device__ __forceinline__ void phase_combine(int l, LAS unsigned char* lds, int G) {
    const int tid = fresh_tid(), lane = tid & 63, wave = __builtin_amdgcn_readfirstlane(tid >> 6);
    const KParams P = fresh_params(); unsigned char* ws = P->ws;
    const bf16r* PROJ = (const bf16r*)(ws + WS_PROJ); const bf16r* OC = (const bf16r*)(ws + WS_OC);
    const bf16r* YT = (const bf16r*)(ws + WS_YT); bf16r* Y = (bf16r*)(ws + WS_H);
    const float* cw = P->in[9] + l * 3 * 768; const float* cbv = P->in[10] + l * 768; const float* scw = P->in[25] + l * 3 * 256; const float* subln = P->in[24] + l * 64;
    float lam;
    { float s1 = 0.f, s2 = 0.f;
      for (int i = 0; i < 32; ++i) { s1 += P->in[20][l * 32 + i] * P->in[21][l * 32 + i]; s2 += P->in[22][l * 32 + i] * P->in[23][l * 32 + i]; }
      lam = expf(s1) - expf(s2) + P->lam_init[l]; }
    const float oml = 1.0f - P->lam_init[l];
    LAS bf16r* yt = (LAS bf16r*)lds;
    const int c8 = tid & 31, rgp = tid >> 5, c = 8 * c8;
    for (int tile = blockIdx.x; tile < MROWS / 64; tile += G) {
        const int b = tile >> 6, t0 = (tile & 63) * 64; const size_t row0 = (size_t)tile * 64;
        const int tl0 = 4 * rgp, tb = t0 + tl0;
        const bf16r* base = PROJ + (row0 + tl0) * DIN + c;
        v4u xw[6]; float uw[6][8];
#pragma unroll
        for (int q = 0; q < 6; ++q) { const int t = tb + q - 1; const bool ok = (t >= 0) && (t < SEQ);
            v4u a = (v4u){0u, 0u, 0u, 0u}, g = a;
            if (ok) { const bf16r* pr = base + (long)(q - 1) * DIN; a = *(const v4u*)(pr + C_BP); g = *(const v4u*)(pr + C_DP + 256); }
            xw[q] = a; unpack8(g, uw[q]); }
#pragma unroll 8
        for (int i = 0; i < 16; ++i) { const int cc = 32 * wave + 2 * i + (lane >> 5), tl = 2 * (lane & 31);
            *(LAS unsigned*)(yt + cc * YTP + tl) = *(const unsigned*)(YT + ((size_t)cc * BATCH + b) * SEQ + t0 + tl); }
        __syncthreads();
#pragma unroll
        for (int r = 0; r < 4; ++r) {
            const bf16r* pr = base + (size_t)r * DIN; const size_t row = row0 + tl0 + r;
            bf16r* yrow = Y + row * DMODEL + c;
            float g[8], o[8], y[8];
            { unpack8(*(const v4u*)(pr + C_BG), g); float xa[8], xb[8], xc[8]; unpack8(xw[r], xa); unpack8(xw[r + 1], xb); unpack8(xw[r + 2], xc);
#pragma unroll
              for (int e = 0; e < 8; ++e) { const float x0 = cw[c + e] * xa[e] + cw[768 + c + e] * xb[e] + cw[1536 + c + e] * xc[e] + cbv[c + e];
                  y[e] = silu_f(g[e]) * x0 * bf1(yt[(c + e) * YTP + tl0 + r]); }
              *(v4u*)(yrow + 256) = pack8(y); }
            { unpack8(*(const v4u*)(pr + C_DP), o);
#pragma unroll
              for (int e = 0; e < 8; ++e) y[e] = o[e] * (scw[c + e] * uw[r][e] + scw[256 + c + e] * uw[r + 1][e] + scw[512 + c + e] * uw[r + 2][e]);
              *(v4u*)(yrow + 768) = pack8(y); }
        }
        __syncthreads();
    }
}

struct EpiProj {
    static constexpr bool PERM = false, AFTER_DRAIN = false;
    int l;
    __device__ __forceinline__ static v2u pk4(float a, float b, float c, float d) { v2u o; o.x = pg8::cvt_pk_bf16(a, b); o.y = pg8::cvt_pk_bf16(c, d); return o; }
    __device__ __forceinline__ static void store_pair16(bf16r* blk, int fq, v2u o1, v2u o2) {
        const auto sx = __builtin_amdgcn_permlane16_swap(o1.x, o2.x, false, false); const auto sy = __builtin_amdgcn_permlane16_swap(o1.y, o2.y, false, false);
        v4u w; w.x = sx[0]; w.y = sy[0]; w.z = sx[1]; w.w = sy[1];
        *(v4u*)(blk + ((fq & 1) ? 16 + 4 * (fq - 1) : 4 * fq)) = w;
    }
    __device__ __forceinline__ void head64(const pg8::f32x4 (&acc)[2][2][4][2], int row0, int fq, bf16r* dst, int pitch, int colbase, const float* gain, float scale, const float2* trc) const {
        pg8::f32x4 g[2][2], rcs[2][2];
#pragma unroll
        for (int bj = 0; bj < 2; ++bj) { g[bj][0] = *(const pg8::f32x4*)(gain + 32 * bj + 4 * fq); g[bj][1] = *(const pg8::f32x4*)(gain + 32 * bj + 16 + 4 * fq); }
#pragma unroll
        for (int ai = 0; ai < 2; ++ai) { const float2* tab = trc + (((row0 + ai * 128) & (SEQ - 1)) >> 6) * 16 + 4 * fq; rcs[ai][0] = *(const pg8::f32x4*)tab; rcs[ai][1] = *(const pg8::f32x4*)(tab + 2); }
#pragma unroll
        for (int mh = 0; mh < 2; ++mh) {
            pg8::f32x4 ccs[2][2];
#pragma unroll
            for (int mm = 0; mm < 2; ++mm) { const float2* tab = trc + ((row0 + (2 * mh + mm) * 16) & 63) * 16 + 4 * fq; ccs[mm][0] = *(const pg8::f32x4*)tab; ccs[mm][1] = *(const pg8::f32x4*)(tab + 2); }
            asm volatile("" ::: "memory");
#pragma unroll
        for (int mm = 0; mm < 2; ++mm)
#pragma unroll
            for (int ai = 0; ai < 2; ++ai) { const int m = 2 * mh + mm; const int row = row0 + ai * 128 + m * 16;
                float ss = 0.f;
#pragma unroll
                for (int bj = 0; bj < 2; ++bj)
#pragma unroll
                    for (int n = 0; n < 2; ++n) { const pg8::f32x4 v = acc[ai][bj][m][n]; ss += (v[0] * v[0] + v[1] * v[1]) + (v[2] * v[2] + v[3] * v[3]); }
                ss += __shfl_xor(ss, 16); ss += __shfl_xor(ss, 32);
                const float rstd = rsqrtf(ss * (1.f / 64.f) + EPS);
#pragma unroll
                for (int bj = 0; bj < 2; ++bj) { const pg8::f32x4 cs01 = bj == 0 ? rcs[ai][0] : ccs[mm][0], cs23 = bj == 0 ? rcs[ai][1] : ccs[mm][1];
                    const pg8::f32x4 x1 = acc[ai][bj][m][0] * g[bj][0] * (rstd * scale), x2 = acc[ai][bj][m][1] * g[bj][1] * (rstd * scale);
                    const float c0 = cs01[0], s0 = cs01[1], c1 = cs01[2], s1 = cs01[3], c2 = cs23[0], s2 = cs23[1], c3 = cs23[2], s3 = cs23[3];
                    store_pair16(dst + (size_t)row * pitch + colbase + 32 * bj, fq, pk4(x1[0] * c0 - x2[0] * s0, x1[1] * c1 - x2[1] * s1, x1[2] * c2 - x2[2] * s2, x1[3] * c3 - x2[3] * s3),
                                 pk4(x2[0] * c0 + x1[0] * s0, x2[1] * c1 + x1[1] * s1, x2[2] * c2 + x1[2] * s2, x2[3] * c3 + x1[3] * s3)); } } }
    }
    __device__ __forceinline__ void sub32(const pg8::f32x4 (&acc)[2][2][4][2], int row0, int wc, int fq, bf16r* dst, const float* gain, float scale, const float2* tseq) const {
        const pg8::f32x4 g1 = *(const pg8::f32x4*)(gain + 4 * fq), g2 = *(const pg8::f32x4*)(gain + 16 + 4 * fq);
#pragma unroll
        for (int ai = 0; ai < 2; ++ai) {
            pg8::f32x4 cs[4][2];
#pragma unroll
            for (int m = 0; m < 4; ++m) { const float2* tab = tseq + ((row0 + ai * 128 + m * 16) & (SEQ - 1)) * 16 + 4 * fq; cs[m][0] = *(const pg8::f32x4*)tab; cs[m][1] = *(const pg8::f32x4*)(tab + 2); }
            asm volatile("" ::: "memory");
#pragma unroll
            for (int m = 0; m < 4; ++m) { const int row = row0 + ai * 128 + m * 16;
                const pg8::f32x4 cs01 = cs[m][0], cs23 = cs[m][1];
                const float c0 = cs01[0], s0 = cs01[1], c1 = cs01[2], s1 = cs01[3], c2 = cs23[0], s2 = cs23[1], c3 = cs23[2], s3 = cs23[3];
#pragma unroll
                for (int bj = 0; bj < 2; ++bj) { const pg8::f32x4 a = acc[ai][bj][m][0], b = acc[ai][bj][m][1];
                    float ss = ((a[0] * a[0] + a[1] * a[1]) + (a[2] * a[2] + a[3] * a[3])) + ((b[0] * b[0] + b[1] * b[1]) + (b[2] * b[2] + b[3] * b[3]));
                    ss += __shfl_xor(ss, 16); ss += __shfl_xor(ss, 32);
                    const float rs = rsqrtf(ss * (1.f / 32.f) + EPS) * scale;
                    const pg8::f32x4 x1 = a * g1 * rs, x2 = b * g2 * rs;
                    store_pair16(dst + (size_t)row * 256 + (4 * bj + wc) * 32, fq, pk4(x1[0] * c0 - x2[0] * s0, x1[1] * c1 - x2[1] * s1, x1[2] * c2 - x2[2] * s2, x1[3] * c3 - x2[3] * s3),
                                 pk4(x2[0] * c0 + x1[0] * s0, x2[1] * c1 + x1[1] * s1, x2[2] * c2 + x1[2] * s2, x2[3] * c3 + x1[3] * s3));
                    } } }
    }
    __device__ __forceinline__ void plain(const pg8::f32x4 (&acc)[2][2][4][2], int row0, bf16r* dst0, int off_bj1) const {
#pragma unroll
        for (int ai = 0; ai < 2; ++ai)
#pragma unroll
            for (int m = 0; m < 4; ++m) { bf16r* d = dst0 + (size_t)(row0 + ai * 128 + m * 16) * DIN;
#pragma unroll
                for (int bj = 0; bj < 2; ++bj) { const pg8::f32x4 v0 = acc[ai][bj][m][0], v1 = acc[ai][bj][m][1];
                    v4u w; w.x = pg8::cvt_pk_bf16(v0[0], v0[1]); w.y = pg8::cvt_pk_bf16(v0[2], v0[3]); w.z = pg8::cvt_pk_bf16(v1[0], v1[1]); w.w = pg8::cvt_pk_bf16(v1[2], v1[3]);
                    *(v4u*)(d + bj * off_bj1) = w; } }
    }
    template <bool SILU> __device__ __forceinline__ void pairmul(const pg8::f32x4 (&acc)[2][2][4][2], int row0, bf16r* dst0) const {
#pragma unroll
        for (int ai = 0; ai < 2; ++ai)
#pragma unroll
            for (int m = 0; m < 4; ++m) { float y[8];
#pragma unroll
                for (int n = 0; n < 2; ++n)
#pragma unroll
                    for (int e = 0; e < 4; ++e) { const float p = acc[ai][0][m][n][e], q = acc[ai][1][m][n][e]; y[4 * n + e] = SILU ? silu_f(q) * p : p * q; }
                *(v4u*)(dst0 + (size_t)(row0 + ai * 128 + m * 16) * DIN) = pack8(y); }
    }
    __device__ __forceinline__ static v2u quadT(const pg8::f32x4 v, bool o1, bool o2) {
        const float p0 = __shfl_xor(o1 ? v[0] : v[1], 1), p1 = __shfl_xor(o1 ? v[2] : v[3], 1);
        const float a0 = o1 ? p0 : v[0], a1 = o1 ? v[1] : p0, a2 = o1 ? p1 : v[2], a3 = o1 ? v[3] : p1;
        const float r0 = __shfl_xor(o2 ? a0 : a2, 2), r1 = __shfl_xor(o2 ? a1 : a3, 2);
        return pk4(o2 ? r0 : a0, o2 ? r1 : a1, o2 ? a2 : r0, o2 ? a3 : r1);
    }
    __device__ __forceinline__ void transposed(const pg8::f32x4 (&acc)[2][2][4][2], int row0, int fr, bf16r* dstT, int cbase) const {
        const int q = fr & 3; const bool o1 = q & 1, o2 = q & 2, up = fr & 4;
#pragma unroll
        for (int ai = 0; ai < 2; ++ai)
#pragma unroll
            for (int m = 0; m < 4; ++m) { const int row = row0 + ai * 128 + m * 16, b = row >> 12, t8 = (row & (SEQ - 1)) & ~7;
#pragma unroll
                for (int bj = 0; bj < 2; ++bj) { const v2u k0 = quadT(acc[ai][bj][m][0], o1, o2), k1 = quadT(acc[ai][bj][m][1], o1, o2);
                    const unsigned rx = __shfl_xor(up ? k0.x : k1.x, 4), ry = __shfl_xor(up ? k0.y : k1.y, 4);
                    v4u w; if (up) { w.x = rx; w.y = ry; w.z = k1.x; w.w = k1.y; } else { w.x = k0.x; w.y = k0.y; w.z = rx; w.w = ry; }
                    const int cc = 128 * bj + cbase + (up ? 16 : 0) + q;
                    *(v4u*)(dstT + ((size_t)cc * BATCH + b) * SEQ + t8) = w; } }
    }
    __device__ __forceinline__ void operator()(const pg8::f32x4 (&acc)[2][2][4][2], const pg8::Unit& u, int wr, int wc, int fr, int fq) const {
        constexpr float L2E = 1.4426950408889634f;
        const int row0 = u.pm * 256 + wr * 64 + fr, pn = win_p2l(u.pn);
        const KParams P = fresh_params(); unsigned char* ws = P->ws;
        bf16r* PROJ = (bf16r*)(ws + WS_PROJ); bf16r* QA = (bf16r*)(ws + WS_QA); bf16r* KA = (bf16r*)(ws + WS_KA); bf16r* QC = (bf16r*)(ws + WS_QC); bf16r* KC = (bf16r*)(ws + WS_KC);
        bf16r* X1T = (bf16r*)(ws + WS_ZT); bf16r* VT = (bf16r*)(ws + WS_OA);
        const float* aqn = P->in[7] + l * 64; const float* akn = P->in[8] + l * 64; const float* cqn = P->in[18] + l * 32; const float* ckn = P->in[19] + l * 32;
        const float2* tseq = (const float2*)(ws + WS_TABSEQ); const float2* trc = (const float2*)(ws + WS_TABRC);
        if (pn == 0) head64(acc, row0, fq, QA, 256, 64 * wc, aqn, 0.125f * L2E, trc);
        else if (pn == 1) { if (wc < 2) head64(acc, row0, fq, KA, 128, 64 * wc, akn, 1.0f, trc);
                            else plain(acc, row0, PROJ + C_AV + 32 * (wc - 2) + 8 * fq, 64); }
        else if (pn == 7) sub32(acc, row0, wc, fq, QC, cqn, 0.17677669529663687f * L2E, tseq);
        else if (pn == 8) sub32(acc, row0, wc, fq, KC, ckn, 1.0f, tseq);
        else if (pn == 11 || pn == 12) pairmul<true>(acc, row0, PROJ + C_DP + 128 * (pn - 11) + 32 * wc + 8 * fq);
        else if (pn == 13 || pn == 14) pairmul<false>(acc, row0, PROJ + C_DP + 256 + 128 * (pn - 13) + 32 * wc + 8 * fq);
        else if (pn == 4) transposed(acc, row0, fr, X1T, 32 * wc + 4 * fq);
        else if (pn == 5) transposed(acc, row0, fr, VT, 32 * wc + 4 * fq);
        else plain(acc, row0, PROJ + pn * 256 + 32 * wc + 8 * fq, 128);
    }
};

struct EpiGateBf16 {
    static constexpr bool PERM = true, AFTER_DRAIN = false;
    pg8::bf16_t* O; const float* gate; int pitch; bool park;
    __device__ __forceinline__ void operator()(const pg8::f32x4 (&acc)[2][2][4][2], const pg8::Unit& u, int wr, int wc, int fr, int fq) const {
        const int row0 = u.pm * 256 + wr * 64 + fr, col0 = u.pn * 256 + wc * 32 + 8 * fq;
        const float* gb = gate + (u.pm >> 4) * 3072 + col0;
        pg8::f32x4 gv[2][2];
#pragma unroll
        for (int bj = 0; bj < 2; ++bj)
#pragma unroll
            for (int n = 0; n < 2; ++n) gv[bj][n] = *(const pg8::f32x4*)(gb + bj * 128 + 4 * n);
        int cmap[2];
#pragma unroll
        for (int bj = 0; bj < 2; ++bj) cmap[bj] = park ? d0_col(col0 + bj * 128) : col0 + bj * 128;
#pragma unroll
        for (int ai = 0; ai < 2; ++ai)
#pragma unroll
            for (int m = 0; m < 4; ++m) { pg8::bf16_t* rowp = O + (size_t)(row0 + ai * 128 + m * 16) * pitch;
#pragma unroll
                for (int bj = 0; bj < 2; ++bj) { const pg8::f32x4 v0 = acc[ai][bj][m][0] * gv[bj][0], v1 = acc[ai][bj][m][1] * gv[bj][1];
                    pg8::u32x4 w; w.x = pg8::cvt_pk_bf16(v0[0], v0[1]); w.y = pg8::cvt_pk_bf16(v0[2], v0[3]); w.z = pg8::cvt_pk_bf16(v1[0], v1[1]); w.w = pg8::cvt_pk_bf16(v1[2], v1[3]);
                    *(pg8::u32x4*)(rowp + cmap[bj]) = w; } }
    }
};

__device__ __forceinline__ void phase_gemm1(int l, LAS unsigned char* lds, int G, int bx) {
    const KParams P = fresh_params(); unsigned char* ws = P->ws;
    pg8::Gemm g{(const pg8::bf16_t*)(ws + WS_H), (const pg8::bf16_t*)(ws + WS_WIN) + (size_t)l * DIN * DMODEL, MROWS, DIN, DMODEL};
    pg8::StaticOrder S; S.init(MROWS, DIN, G, bx);
    EpiProj E{l};
    pg8::gemm_phase<EpiProj, pg8::StaticOrder, PG8_ALIGN, PG8_SP2>(lds, g, S, E);
}
__device__ __forceinline__ void phase_gemm2(int l, LAS unsigned char* lds, int G, int bx) {
    const KParams P = fresh_params(); unsigned char* ws = P->ws;
    pg8::Gemm g{(const pg8::bf16_t*)(ws + WS_H), (const pg8::bf16_t*)(ws + WS_WOUT) + (size_t)l * DMODEL * DMODEL, MROWS, DMODEL, DMODEL};
    pg8::StaticOrder S; S.init(MROWS, DMODEL, G, bx);
    EpiGateBf16 E{(pg8::bf16_t*)(ws + (l == 0 ? WS_PROJ : WS_DELTA)), (const float*)(ws + WS_MOD) + (size_t)l * 8 * 3072 + 2048, l == 0 ? DIN : DMODEL, l == 0};
    pg8::gemm_phase<EpiGateBf16, pg8::StaticOrder, PG8_ALIGN, PG8_SP2>(lds, g, S, E);
}
__device__ __forceinline__ void phase_final(int vcu, int G) {
    const KParams P = fresh_params(); unsigned char* ws = P->ws;
    const int tid = fresh_tid();
    float* out = P->out; const float* xin = P->in[0]; const bf16r* DL = (const bf16r*)(ws + WS_DELTA); const bf16r* D0 = (const bf16r*)(ws + WS_PROJ);
    const unsigned n8 = (unsigned)MROWS * DMODEL / 8;
    for (unsigned i = (unsigned)vcu * NTHR + tid; i < n8; i += (unsigned)G * NTHR) {
        const unsigned row = i >> 7, col = (i & 127) * 8;
        const v4u d = *(const v4u*)(DL + (size_t)i * 8), e = *(const v4u*)(D0 + (size_t)row * DIN + d0_col((int)col));
        f32x4 a = *(const f32x4*)(xin + (size_t)i * 8), b = *(const f32x4*)(xin + (size_t)i * 8 + 4);
        a.x += bflo(d.x) + bflo(e.x); a.y += bfhi(d.x) + bfhi(e.x); a.z += bflo(d.y) + bflo(e.y); a.w += bfhi(d.y) + bfhi(e.y);
        b.x += bflo(d.z) + bflo(e.z); b.y += bfhi(d.z) + bfhi(e.z); b.z += bflo(d.w) + bflo(e.w); b.w += bfhi(d.w) + bfhi(e.w);
        *(f32x4*)(out + (size_t)i * 8) = a; *(f32x4*)(out + (size_t)i * 8 + 4) = b; }
}
__device__ __forceinline__ void phase_attn(int l, char* lds_generic, int vcu, int G) {
    const KParams P = fresh_params(); unsigned char* ws = P->ws;
    using abf = attn_body::bf16;
    float bA, bC;
    { float gq = 0.f, gk = 0.f, cq = 0.f, ck = 0.f;
      for (int i = 0; i < 64; ++i) { gq = fmaxf(gq, fabsf(P->in[7][l * 64 + i])); gk = fmaxf(gk, fabsf(P->in[8][l * 64 + i])); }
      for (int i = 0; i < 32; ++i) { cq = fmaxf(cq, fabsf(P->in[18][l * 32 + i])); ck = fmaxf(ck, fabsf(P->in[19][l * 32 + i])); }
      bA = 64.f * 0.125f * 1.4426950408889634f * 1.03f * gq * gk; bC = 32.f * 0.17677669529663687f * 1.4426950408889634f * 1.03f * cq * ck; }
    const bool fix = (bA < 40.f) && (bC < 40.f);
    float lam;
    { float s1 = 0.f, s2 = 0.f;
      for (int i = 0; i < 32; ++i) { s1 += P->in[20][l * 32 + i] * P->in[21][l * 32 + i]; s2 += P->in[22][l * 32 + i] * P->in[23][l * 32 + i]; }
      lam = expf(s1) - expf(s2) + P->lam_init[l]; }
    const float oml = 1.0f - P->lam_init[l]; const float* subln = P->in[24] + l * 64;
#define ATTN_A_ARGS \
        const int grp = u >> 4, qb = u & 15, b = grp >> 2, h = grp & 3; \
        const abf* Q = (const abf*)(ws + WS_QA) + h * 64; const abf* K = (const abf*)(ws + WS_KA) + (h >> 1) * 64; const abf* V = (const abf*)(ws + WS_PROJ) + C_AV + (h >> 1) * 64; \
        abf* O = (abf*)(ws + WS_H) + h * 64; const abf* Gt = (const abf*)(ws + WS_PROJ) + C_AG + h * 64;
#define ATTN_C_ARGS \
        const int cgp = du >> 4, qb = du & 15, b = cgp >> 2, hd = cgp & 3, h = 2 * hd + mp; \
        const abf* Q = (const abf*)(ws + WS_QC) + h * 32; const abf* K = (const abf*)(ws + WS_KC) + h * 32; const abf* V = (const abf*)(ws + WS_PROJ) + C_CV + hd * 64; \
        abf* O = (abf*)(ws + WS_H) + 512 + hd * 64; \
        const abf* Gt = mp ? (const abf*)(ws + WS_PROJ) + C_CG + hd * 64 : (const abf*)nullptr;
    attn_body::u32x4 okeep[4] = {};
    if (fix) {
        for (int u = vcu; u < 32 * 16; u += G) { ATTN_A_ARGS
            attn_body::attn_unit<8, true, false>(bA, (long)b * SEQ, qb * 256, Q, 256, K, 128, V, DIN, O, DMODEL, Gt, DIN, okeep, 0, 0.f, 0.f, subln, lds_generic); }
        for (int du = vcu; du < 32 * 16; du += G)
            for (int mp = 0; mp < 2; ++mp) { ATTN_C_ARGS
                attn_body::attn_unit<8, true, true>(bC, (long)b * SEQ, qb * 256, Q, 256, K, 256, V, DIN, O, DMODEL, Gt, DIN, okeep, 1 + mp, lam, oml, subln, lds_generic); }
    } else {
        for (int u = vcu; u < 32 * 16; u += G) { ATTN_A_ARGS
            attn_body::attn_unit<8, false, false>(0.f, (long)b * SEQ, qb * 256, Q, 256, K, 128, V, DIN, O, DMODEL, Gt, DIN, okeep, 0, 0.f, 0.f, subln, lds_generic); }
        for (int du = vcu; du < 32 * 16; du += G)
            for (int mp = 0; mp < 2; ++mp) { ATTN_C_ARGS
                attn_body::attn_unit<8, false, true>(0.f, (long)b * SEQ, qb * 256, Q, 256, K, 256, V, DIN, O, DMODEL, Gt, DIN, okeep, 1 + mp, lam, oml, subln, lds_generic); }
    }
#undef ATTN_A_ARGS
#undef ATTN_C_ARGS
}
#define XB_TMO      128
#define XB_XCNT(j)  (256  + 64 * (j))
#define XB_XSUB(j)  (1280 + 64 * (j))
#define XB_XGEN(j)  (2304 + 64 * (j))
#define XB_TOP      3328
#define XB_TOPGEN   3392
#define XCD_BAR_WORDS 3456
#define XB_SPIN_CAP (1u << 18)

__device__ __forceinline__ unsigned xb_ld(unsigned* p)              { return __hip_atomic_load(p, __ATOMIC_RELAXED, __HIP_MEMORY_SCOPE_AGENT); }
__device__ __forceinline__ unsigned xb_add(unsigned* p, unsigned v) { return __hip_atomic_fetch_add(p, v, __ATOMIC_RELAXED, __HIP_MEMORY_SCOPE_AGENT); }
__device__ __forceinline__ unsigned xb_xcc_id() { return (unsigned)__builtin_amdgcn_s_getreg((3 << 11) | 20) & 0xFu; }
#define XB_SPIN(cond, bar) do { unsigned _sp = 0; while (cond) { __builtin_amdgcn_s_sleep(1); \
    if ((++_sp & 255u) == 0u) { if (xb_ld(&(bar)[XB_TMO])) break; if (_sp > XB_SPIN_CAP) { atomicAdd(&(bar)[XB_TMO], 1u); break; } } } } while (0)

struct XcdBarrier {
    unsigned* bar; unsigned x;
    volatile LAS unsigned* st;
};

__device__ __forceinline__ XcdBarrier xcd_barrier_post(unsigned* bar, volatile LAS unsigned* st) {
    XcdBarrier b; b.bar = bar; b.x = xb_xcc_id(); b.st = st;
    if (threadIdx.x == 0) (void)xb_add(&bar[XB_XCNT(b.x)], 1u);
    return b;
}
__device__ __forceinline__ void xcd_barrier_complete(unsigned* bar, unsigned x, unsigned& nloc, unsigned& nx) {
    const unsigned G = gridDim.x * gridDim.y * gridDim.z;
    unsigned sum, cnt, mine, sp = 0u;
    for (;;) {
        sum = 0u; cnt = 0u; mine = 0u;
#pragma unroll
        for (unsigned j = 0; j < 16; ++j) { const unsigned c = xb_ld(&bar[XB_XCNT(j)]); sum += c; cnt += (c > 0u) ? 1u : 0u; mine = (j == x) ? c : mine; }
        if (sum == G) break;
        __builtin_amdgcn_s_sleep(1);
        if ((++sp & 255u) == 0u) { if (xb_ld(&bar[XB_TMO])) break; if (sp > XB_SPIN_CAP) { atomicAdd(&bar[XB_TMO], 1u); break; } }
    }
    nloc = mine > 0u ? mine : 1u; nx = cnt > 0u ? cnt : 1u;
}

__device__ __forceinline__ void xcd_barrier(const XcdBarrier& b) {
    asm volatile("s_waitcnt vmcnt(0)" ::: "memory");
    __syncthreads();
    if (threadIdx.x == 0) {
        unsigned* bar = b.bar;
        __builtin_amdgcn_s_waitcnt(0);
        unsigned nloc = b.st[0], nx = b.st[1];
        if (nloc == 0u) { xcd_barrier_complete(bar, b.x, nloc, nx); b.st[0] = nloc; b.st[1] = nx; }
        const unsigned old = xb_add(&bar[XB_XSUB(b.x)], 1u);
        const unsigned gen = old / nloc;
        if (old + 1u == (gen + 1u) * nloc) {
            __builtin_amdgcn_fence(__ATOMIC_RELEASE, "agent");
            asm volatile("s_waitcnt vmcnt(0)" ::: "memory");
            const unsigned og = xb_add(&bar[XB_TOP], 1u);
            const unsigned tg = og / nx;
            if (og + 1u == (tg + 1u) * nx) xb_add(&bar[XB_TOPGEN], 1u);
            else XB_SPIN(xb_ld(&bar[XB_TOPGEN]) == tg, bar);
            __builtin_amdgcn_fence(__ATOMIC_ACQUIRE, "agent");
            xb_add(&bar[XB_XGEN(b.x)], 1u);
            asm volatile("s_waitcnt vmcnt(0)" ::: "memory");
        } else {
            XB_SPIN(xb_ld(&bar[XB_XGEN(b.x)]) == gen, bar);
            __builtin_amdgcn_fence(__ATOMIC_ACQUIRE, "agent");
            asm volatile("s_waitcnt vmcnt(0)" ::: "memory");
        }
    }
    __syncthreads();
}

#ifndef PM
#define PM 255
#endif
#ifndef REP_G2L0
#define REP_G2L0 1
#endif
#ifndef REP_PRO
#define REP_PRO 1
#endif
#ifndef REP_NORM
#define REP_NORM 1
#endif
#ifndef REP_G1
#define REP_G1 1
#endif
#ifndef REP_PREP
#define REP_PREP 1
#endif
#ifndef REP_ATTN
#define REP_ATTN 1
#endif
#ifndef REP_HY
#define REP_HY 1
#endif
#ifndef REP_COMB
#define REP_COMB 1
#endif
#ifndef REP_SYNC
#define REP_SYNC 1
#endif
__global__ void __launch_bounds__(NTHR, 2) hymba_fwd(Params Pk) {
    extern __shared__ __attribute__((aligned(16))) unsigned char lds_raw[];
    LAS unsigned char* lds = (LAS unsigned char*)lds_raw;
    cg::grid_group grid = cg::this_grid();
    const int G = gridDim.x, bx = blockIdx.x, vcu = (G % 8 == 0) ? (bx % 8) * (G / 8) + bx / 8 : bx;
    if (threadIdx.x < 8) ((LAS unsigned*)(lds + MISC_OFF))[threadIdx.x] = 0u;
    __syncthreads();
    XcdBarrier bar = xcd_barrier_post((unsigned*)(fresh_params()->ws + WS_BAR), (volatile LAS unsigned*)(lds + MISC_OFF));
#define GSYNC() xcd_barrier(bar)
#if PM & 1
    for (int rp = 0; rp < REP_PRO; ++rp) phase_prologue(lds, vcu, G, rp == 0);
#endif
    if (G == 0x7fffffff) grid.sync();
    GSYNC();
    for (int l = 0; l < DEPTH; ++l) {
#if PM & 2
        for (int rp = 0; rp < REP_NORM; ++rp) phase_norm(l, vcu, G);
#endif
        GSYNC();
#if PM & 4
        for (int rp = 0; rp < REP_G1; ++rp) phase_gemm1(l, lds, G, bx);
#endif
        GSYNC();
#if PM & 16
        for (int rp = 0; rp < REP_ATTN; ++rp) phase_attn(l, (char*)lds_raw, vcu, G);
        __syncthreads();
#endif
#if PM & 32
        for (int rp = 0; rp < REP_HY; ++rp) phase_hyena(l, lds, G);
#endif
        GSYNC();
#if PM & 64
        for (int rp = 0; rp < REP_COMB; ++rp) phase_combine(l, lds, G);
#endif
        GSYNC();
#if PM & 128
        for (int rp = 0; rp < REP_G2L0; ++rp) phase_gemm2(l, lds, G, bx);
#endif
        for (int rp = 0; rp < REP_SYNC; ++rp) GSYNC();
    }
    phase_final(vcu, G);
}

extern "C" void kernel_launch(void* const* d_in, const int* in_sizes, int n_in, void* d_out, int out_size, void* d_ws, size_t ws_size, hipStream_t stream) {
    static int grid = 0;
    if (grid == 0) {
        if (n_in != 26 || out_size != MROWS * DMODEL || ws_size < WS_END) { fprintf(stderr, "kernel_launch: unexpected shapes (n_in %d out %d ws %zu)\n", n_in, out_size, ws_size); grid = -1; return; }
        int dev = 0, cus = 0, per_cu = 0;
        hipGetDevice(&dev); hipDeviceGetAttribute(&cus, hipDeviceAttributeMultiprocessorCount, dev);
        if (hipFuncSetAttribute((const void*)hymba_fwd, hipFuncAttributeMaxDynamicSharedMemorySize, LDS_BYTES) != hipSuccess) { fprintf(stderr, "hipFuncSetAttribute failed\n"); grid = -1; return; }
        if (hipOccupancyMaxActiveBlocksPerMultiprocessor(&per_cu, (const void*)hymba_fwd, NTHR, LDS_BYTES) != hipSuccess || per_cu < 1) { fprintf(stderr, "occupancy query: %d\n", per_cu); per_cu = 1; }
        (void)hipGetLastError();
        grid = cus * 1;
    }
    if (grid < 0) return;
    hipMemsetAsync((char*)d_ws + WS_CTL, 0, CTL_ZERO_BYTES, stream);
    Params p{};
    for (int i = 0; i < 26; ++i) p.in[i] = (const float*)d_in[i];
    p.out = (float*)d_out; p.ws = (unsigned char*)d_ws;
    for (int i = 0; i < 16; ++i) p.inv[i] = (float)pow(10000.0, -(double)i / 16.0);
    for (int l = 0; l < 2; ++l) p.lam_init[l] = (float)(0.8 - 0.6 * exp(-0.3 * (double)l));
    void* args[] = {&p};
    hipError_t e = hipLaunchCooperativeKernel((const void*)hymba_fwd, dim3(grid), dim3(NTHR), args, LDS_BYTES, stream);
    if (e != hipSuccess) fprintf(stderr, "cooperative launch failed: %s (grid %d)\n", hipGetErrorString(e), grid);
}
```

```cpp
#include <hip/hip_cooperative_groups.h>
#include <hip/hip_runtime.h>
#include <cstdio>
#include <cstdint>
__device__ __forceinline__ int fresh_tid() { int t = threadIdx.x; asm volatile("" : "+v"(t)); return t; }
namespace pg8 {
#define PG8_LAS __attribute__((address_space(3)))
typedef unsigned short bf16_t;
typedef short bf16x8 __attribute__((ext_vector_type(8)));
typedef float f32x4 __attribute__((ext_vector_type(4)));
typedef unsigned u32x4 __attribute__((ext_vector_type(4)));
constexpr int BM = 256, BK = 64, HALF = 128, HTB = HALF * BK * 2  , STAGE_BYTES = 8 * HTB, NXCD = 8, WGM = 8;

__host__ __device__ __forceinline__ int lds_byte(int r, int c) { const int st = (r >> 4) * 2 + (c >> 5), rr = r & 15, cc = c & 31, ob = rr * 64 + cc * 2; return st * 1024 + (ob ^ (((ob >> 9) & 1) << 5)); }
__host__ __device__ __forceinline__ void stage_rc(int b, int& R, int& C) { const int st = b / 1024, sb = b % 1024, swz = sb ^ (((sb >> 9) & 1) << 5); R = (st >> 1) * 16 + swz / 64; C = (st & 1) * 32 + (swz % 64) / 2; }
__host__ __device__ __forceinline__ int perm32(int rho) { const int n = rho >> 4, i = rho & 15; return 8 * (i >> 2) + 4 * n + (i & 3); }

struct Unit { int pm, pn; };
struct Gemm { const bf16_t* A; const bf16_t* Bt; int M, N, K; };

struct StaticOrder {
    int nM, nN, nwg, G, c;
    __host__ __device__ void init(int M, int N, int G_, int c_) { nM = M / BM; nN = N / BM; nwg = nM * nN; G = G_; c = c_; }
    __host__ __device__ bool next(int i, Unit& u) const {
        const long L = (long)i * G + c; if (L >= nwg) return false;
        int wgid = (int)L; { const int q = nwg / NXCD, r = nwg % NXCD, xcd = wgid % NXCD, off = wgid / NXCD; wgid = (xcd < r ? xcd * (q + 1) : r * (q + 1) + (xcd - r) * q) + off; }
        const int nig = WGM * nN, gid = wgid / nig, fm = gid * WGM, gsz = (nM - fm) < WGM ? (nM - fm) : WGM;
        u.pm = fm + ((wgid % nig) % gsz); u.pn = (wgid % nig) / gsz; return true;
    }
    __device__ __forceinline__ void a_ready(const Unit&) const {}
    __device__ __forceinline__ void done(const Unit&) const {}
};

__device__ __forceinline__ unsigned cvt_pk_bf16(float lo, float hi) { unsigned r; asm volatile("v_cvt_pk_bf16_f32 %0, %1, %2" : "=v"(r) : "v"(lo), "v"(hi)); return r; }
typedef float f32x2 __attribute__((ext_vector_type(2)));
__device__ __forceinline__ f32x2 gelu_pk(f32x2 v) {
    const f32x2 av = __builtin_elementwise_abs(v), d = av * 0.2316418882f + 1.0f;
    f32x2 t; t.x = __builtin_amdgcn_rcpf(d.x); t.y = __builtin_amdgcn_rcpf(d.y);
    f32x2 q = t * 0.5307027145f + (-0.7265760135f); q = q * t + 0.7107068705f; q = q * t + (-0.142248368f); q = q * t + 0.127414796f; q = q * t;
    const f32x2 s = (v * v) * (-0.72134752044f);
    f32x2 e; e.x = __builtin_amdgcn_exp2f(s.x); e.y = __builtin_amdgcn_exp2f(s.y);
    const f32x2 m = v * (q * e), r = v - m;
    f32x2 o; o.x = v.x < 0.f ? m.x : r.x; o.y = v.y < 0.f ? m.y : r.y; return o;
}

template <int ACT  > struct EpiBf16 {
    static constexpr bool PERM = true, AFTER_DRAIN = false; static_assert(ACT == 0 || ACT == 1, "EpiBf16: ACT is 0 (none) or 1 (gelu_pk)");
    bf16_t* O; int ldc; const float* bias; int split_cols; size_t split_stride; float scale0;
    __device__ __forceinline__ void operator()(const f32x4 (&acc)[2][2][4][2], const Unit& u, int wr, int wc, int fr, int fq) const {
        const int row0 = u.pm * BM + wr * 64 + fr; int colt = u.pn * BM; bf16_t* base = O;
        float sc = 1.f; if (split_cols) { const int t = colt / split_cols; base += (size_t)t * split_stride; colt -= t * split_cols; if (t == 0) sc = scale0; }
        const int col0 = colt + wc * 32 + 8 * fq, bcol0 = u.pn * BM + wc * 32 + 8 * fq;
        f32x4 bv[2][2];
#pragma unroll
        for (int bj = 0; bj < 2; ++bj)
#pragma unroll
            for (int n = 0; n < 2; ++n) bv[bj][n] = bias ? *(const f32x4*)(bias + bcol0 + bj * HALF + 4 * n) : (f32x4){0.f, 0.f, 0.f, 0.f};
#pragma unroll
        for (int ai = 0; ai < 2; ++ai)
#pragma unroll
            for (int m = 0; m < 4; ++m) { bf16_t* rowp = base + (size_t)(row0 + ai * HALF + m * 16) * ldc + col0;
#pragma unroll
                for (int bj = 0; bj < 2; ++bj) { f32x4 v0 = acc[ai][bj][m][0] + bv[bj][0], v1 = acc[ai][bj][m][1] + bv[bj][1];
                    if (ACT == 1) { f32x2 a = gelu_pk((f32x2){v0[0], v0[1]}), b = gelu_pk((f32x2){v0[2], v0[3]}), c = gelu_pk((f32x2){v1[0], v1[1]}), d = gelu_pk((f32x2){v1[2], v1[3]});
                        v0 = (f32x4){a.x, a.y, b.x, b.y}; v1 = (f32x4){c.x, c.y, d.x, d.y}; }
                    v0 = v0 * sc; v1 = v1 * sc; u32x4 w; w.x = cvt_pk_bf16(v0[0], v0[1]); w.y = cvt_pk_bf16(v0[2], v0[3]); w.z = cvt_pk_bf16(v1[0], v1[1]); w.w = cvt_pk_bf16(v1[2], v1[3]);
                    *(u32x4*)(rowp + bj * HALF) = w; } }
    }
};
template <class Epi, class Sched, bool ALIGN_EPI = false, bool SP2 = false>
__device__ __forceinline__ void gemm_phase(PG8_LAS unsigned char* lds, const Gemm g, const Sched& S, const Epi& E) {
    const int tid = fresh_tid(), wid = __builtin_amdgcn_readfirstlane(tid >> 6), lane = tid & 63, wr = wid >> 2, wc = wid & 3, fr = lane & 15, fq = lane >> 4;
    const int K = g.K, nt = K / BK;
    unsigned voffA[2], voffB[2];
#pragma unroll
    for (int i = 0; i < 2; ++i) { int R, C; stage_rc(tid * 16 + i * 8192, R, C); const int Rb = Epi::PERM ? ((R & ~31) + perm32(R & 31)) : R;
        voffA[i] = (unsigned)(R * K + C) * 2u; voffB[i] = (unsigned)(Rb * K + C) * 2u; }
    const size_t kstep = (size_t)(BK * 2);
    const size_t hstep = (size_t)HALF * K * 2;
    const size_t tstep = 2 * hstep;
    const unsigned ldsw = (unsigned)wid * 1024u;
    const int aoff = lds_byte(wr * 64 + fr, fq * 8), boff = lds_byte(wc * 32 + fr, fq * 8);
#define PG8_SA(b, h) (((b) * 2 + (h)) * HTB)
#define PG8_SB(b, h) ((4 + (b) * 2 + (h)) * HTB)
#define PG8_STAGE(bufoff, gbase, voff) do { _Pragma("unroll") for (int _i = 0; _i < 2; ++_i) \
        __builtin_amdgcn_global_load_lds((const unsigned*)((const char*)(gbase) + (voff)[_i]), (PG8_LAS unsigned*)(lds + (bufoff) + ldsw + _i * 8192), 16, 0, 0); } while (0)
#define PG8_LDA(dst, b, h) do { _Pragma("unroll") for (int m = 0; m < 4; ++m) _Pragma("unroll") for (int k = 0; k < 2; ++k) dst[m][k] = *(const PG8_LAS bf16x8*)(lds + PG8_SA(b, h) + aoff + m * 2048 + k * 1024); } while (0)
#define PG8_LDB(dst, b, h) do { _Pragma("unroll") for (int n = 0; n < 2; ++n) _Pragma("unroll") for (int k = 0; k < 2; ++k) dst[n][k] = *(const PG8_LAS bf16x8*)(lds + PG8_SB(b, h) + boff + n * 2048 + k * 1024); } while (0)
#define PG8_MMA(ai, bj, At, Bt) do { __builtin_amdgcn_s_setprio(1); _Pragma("unroll") for (int m = 0; m < 4; ++m) _Pragma("unroll") for (int n = 0; n < 2; ++n) _Pragma("unroll") for (int k = 0; k < 2; ++k) \
        acc[ai][bj][m][n] = __builtin_amdgcn_mfma_f32_16x16x32_bf16(Bt[n][k], At[m][k], acc[ai][bj][m][n], 0, 0, 0); __builtin_amdgcn_s_setprio(0); } while (0)
#define PG8_WAIT_V(n) asm volatile("s_waitcnt vmcnt(" #n ")" ::: "memory")
#define PG8_WAIT_L(n) asm volatile("s_waitcnt lgkmcnt(" #n ")" ::: "memory")
#define PG8_BAR __builtin_amdgcn_s_barrier()
#define PG8_SCHED __builtin_amdgcn_sched_barrier(0)
    Unit cur, nxt; int ui = 0;
    if (!S.next(0, cur)) return;
    f32x4 acc[2][2][4][2];
#pragma unroll
    for (int a = 0; a < 2; ++a)
#pragma unroll
        for (int b = 0; b < 2; ++b)
#pragma unroll
            for (int m = 0; m < 4; ++m)
#pragma unroll
                for (int n = 0; n < 2; ++n) acc[a][b][m][n] = (f32x4){0.f, 0.f, 0.f, 0.f};
    bf16x8 At[4][2], B0[2][2], B1[2][2];
    const char* cA = (const char*)g.A + (size_t)cur.pm * tstep; const char* cB = (const char*)g.Bt + (size_t)cur.pn * tstep;
    S.a_ready(cur);
    if constexpr (SP2) {
        PG8_STAGE(PG8_SB(0, 0), cB, voffB); PG8_STAGE(PG8_SB(0, 1), cB + hstep, voffB); PG8_STAGE(PG8_SA(0, 0), cA, voffA); PG8_STAGE(PG8_SA(0, 1), cA + hstep, voffA);
        if (wr == 1) PG8_BAR;
        PG8_WAIT_V(2); PG8_BAR;
        PG8_STAGE(PG8_SB(1, 0), cB + kstep, voffB); PG8_STAGE(PG8_SA(1, 0), cA + kstep, voffA); PG8_STAGE(PG8_SB(1, 1), cB + hstep + kstep, voffB);
        PG8_WAIT_V(6); PG8_BAR;
    } else {
        PG8_STAGE(PG8_SB(0, 0), cB, voffB); PG8_STAGE(PG8_SA(0, 0), cA, voffA); PG8_STAGE(PG8_SB(0, 1), cB + hstep, voffB); PG8_STAGE(PG8_SA(0, 1), cA + hstep, voffA);
        if (wr == 1) PG8_BAR;
        PG8_WAIT_V(4); PG8_BAR;
        PG8_STAGE(PG8_SB(1, 0), cB + kstep, voffB); PG8_STAGE(PG8_SA(1, 0), cA + kstep, voffA); PG8_STAGE(PG8_SB(1, 1), cB + hstep + kstep, voffB);
        PG8_WAIT_V(6); PG8_BAR;
    }
    for (;;) {
        const bool has_next = S.next(ui + 1, nxt);
        const char* nA = has_next ? (const char*)g.A + (size_t)nxt.pm * tstep : cA; const char* nB = has_next ? (const char*)g.Bt + (size_t)nxt.pn * tstep : cB;
        for (int t = 0; t < nt; t += 2) {
            const bool last = (t == nt - 2);
            const char* a1 = cA + (size_t)(t + 1) * kstep;
            const char* a2 = last ? nA : cA + (size_t)(t + 2) * kstep; const char* b2 = last ? nB : cB + (size_t)(t + 2) * kstep;
            const char* a3 = a2 + kstep; const char* b3 = b2 + kstep;
            if (last && has_next) S.a_ready(nxt);
            if constexpr (SP2) {
            PG8_LDB(B0, 0, 0); PG8_LDB(B1, 0, 1); PG8_SCHED; PG8_LDA(At, 0, 0); PG8_STAGE(PG8_SA(1, 1), a1 + hstep, voffA);
            PG8_WAIT_V(8); PG8_WAIT_L(0); PG8_BAR; PG8_MMA(0, 0, At, B0); PG8_MMA(0, 1, At, B1); PG8_BAR; PG8_SCHED;
            PG8_LDA(At, 0, 1); PG8_STAGE(PG8_SB(0, 0), b2, voffB); PG8_STAGE(PG8_SB(0, 1), b2 + hstep, voffB); PG8_STAGE(PG8_SA(0, 0), a2, voffA);
            PG8_WAIT_V(8); PG8_WAIT_L(0); PG8_BAR; PG8_MMA(1, 0, At, B0); PG8_MMA(1, 1, At, B1); PG8_BAR; PG8_SCHED;
            PG8_LDB(B0, 1, 0); PG8_LDB(B1, 1, 1); PG8_SCHED; PG8_LDA(At, 1, 0); PG8_STAGE(PG8_SA(0, 1), a2 + hstep, voffA);
            PG8_WAIT_V(8); PG8_WAIT_L(0); PG8_BAR; PG8_MMA(0, 0, At, B0); PG8_MMA(0, 1, At, B1); PG8_BAR; PG8_SCHED;
            PG8_LDA(At, 1, 1); PG8_STAGE(PG8_SB(1, 0), b3, voffB); PG8_STAGE(PG8_SB(1, 1), b3 + hstep, voffB); PG8_STAGE(PG8_SA(1, 0), a3, voffA);
            PG8_WAIT_V(8); PG8_WAIT_L(0); PG8_BAR; PG8_MMA(1, 0, At, B0); PG8_MMA(1, 1, At, B1); PG8_BAR; PG8_SCHED;
            } else {
            PG8_LDB(B0, 0, 0); PG8_SCHED; PG8_LDA(At, 0, 0); PG8_STAGE(PG8_SA(1, 1), a1 + hstep, voffA);
            PG8_WAIT_L(8); PG8_BAR; PG8_WAIT_L(0); PG8_MMA(0, 0, At, B0); PG8_BAR; PG8_SCHED;
            PG8_LDB(B1, 0, 1); PG8_STAGE(PG8_SB(0, 0), b2, voffB);
            PG8_BAR; PG8_WAIT_L(0); PG8_MMA(0, 1, At, B1); PG8_BAR;
            PG8_LDA(At, 0, 1); PG8_STAGE(PG8_SA(0, 0), a2, voffA);
            PG8_BAR; PG8_WAIT_L(0); PG8_MMA(1, 0, At, B0); PG8_BAR; PG8_SCHED;
            PG8_STAGE(PG8_SB(0, 1), b2 + hstep, voffB);
            PG8_WAIT_V(6); PG8_BAR; PG8_MMA(1, 1, At, B1); PG8_BAR;
            PG8_LDB(B0, 1, 0); PG8_SCHED; PG8_LDA(At, 1, 0); PG8_STAGE(PG8_SA(0, 1), a2 + hstep, voffA);
            PG8_WAIT_L(8); PG8_BAR; PG8_WAIT_L(0); PG8_MMA(0, 0, At, B0); PG8_BAR; PG8_SCHED;
            PG8_LDB(B1, 1, 1); PG8_STAGE(PG8_SB(1, 0), b3, voffB);
            PG8_BAR; PG8_WAIT_L(0); PG8_MMA(0, 1, At, B1); PG8_BAR;
            PG8_LDA(At, 1, 1); PG8_STAGE(PG8_SA(1, 0), a3, voffA);
            PG8_BAR; PG8_WAIT_L(0); PG8_MMA(1, 0, At, B0); PG8_BAR; PG8_SCHED;
            PG8_STAGE(PG8_SB(1, 1), b3 + hstep, voffB);
            PG8_WAIT_V(6); PG8_BAR; PG8_MMA(1, 1, At, B1); PG8_BAR;
            }
        }
        if constexpr (ALIGN_EPI) { if (wr == 0) PG8_BAR; }
        if constexpr (!Epi::AFTER_DRAIN) { E(acc, cur, wr, wc, fr, fq); S.done(cur); }
        if (!has_next) break;
#pragma unroll
        for (int a = 0; a < 2; ++a)
#pragma unroll
            for (int b = 0; b < 2; ++b)
#pragma unroll
                for (int m = 0; m < 4; ++m)
#pragma unroll
                    for (int n = 0; n < 2; ++n) acc[a][b][m][n] = (f32x4){0.f, 0.f, 0.f, 0.f};
        cur = nxt; cA = nA; cB = nB; ++ui;
        if constexpr (ALIGN_EPI) { if (wr == 1) PG8_BAR; }
    }
    PG8_WAIT_V(0);
    if constexpr (!ALIGN_EPI) { if (wr == 0) PG8_BAR; }
    PG8_BAR;
    if constexpr (Epi::AFTER_DRAIN) { E.fused(acc, cur, wr, wc, fr, fq, lds, wid, lane); S.done(cur); }
#undef PG8_SA
#undef PG8_SB
#undef PG8_STAGE
#undef PG8_LDA
#undef PG8_LDB
#undef PG8_MMA
#undef PG8_WAIT_V
#undef PG8_WAIT_L
#undef PG8_BAR
#undef PG8_SCHED
}
}

#ifndef PG8_SP2
#define PG8_SP2 true
#endif
#ifndef PG8_ALIGN
#define PG8_ALIGN true
#endif
#include <hip/hip_bf16.h>
#include <cmath>
namespace attn_body {
using bf16=__hip_bfloat16;
using bf16x8=__attribute__((ext_vector_type(8)))short;
using s16x4=__attribute__((ext_vector_type(4)))short;
using f32x16=__attribute__((ext_vector_type(16)))float;
using u32x4=__attribute__((ext_vector_type(4)))unsigned;
constexpr int SEQ=4096,D=64;
constexpr int NW=8,QBLK=32,QB=QBLK*NW,KVBLK=64,NQB=SEQ/QB;
constexpr int ATTN_UNIT_ROWS=QB;
__device__ __forceinline__ int crow(int r,int hi){return (r&3)+8*(r>>2)+4*hi;}
#define SBAR() __builtin_amdgcn_sched_barrier(0)
constexpr int NSLOT=3, SLOTB=8192;
constexpr int LDS_K=0, LDS_V=NSLOT*SLOTB, LDS_WS=2*NSLOT*SLOTB, LDS_OST=LDS_WS+NW*64*4, LDS_BYTES=LDS_OST+NW*4096;
constexpr int LDS_GST=LDS_BYTES;
constexpr float C2=0.125f*1.4426950408889634f;
__device__ __forceinline__ void glds16(const void*gsrc,unsigned lds_dst){unsigned keep;
  asm volatile("s_mov_b32 %0, m0\n\ts_mov_b32 m0, %2\n\ts_nop 0\n\tglobal_load_lds_dwordx4 %1, off\n\ts_mov_b32 m0, %0":"=&s"(keep):"v"(gsrc),"s"(lds_dst):"memory");}
__device__ __forceinline__ float max3f(float a,float b,float c){float r;asm("v_max3_f32 %0, %1, %2, %3":"=v"(r):"v"(a),"v"(b),"v"(c));return r;}
__device__ __forceinline__ float max2f(float a,float b){float r;asm("v_max_f32_e32 %0, %1, %2":"=v"(r):"v"(a),"v"(b));return r;}
__device__ __forceinline__ float fadd_s(float a,float b){float r;asm("v_add_f32_e32 %0, %1, %2":"=v"(r):"v"(a),"v"(b));return r;}
__device__ __forceinline__ float fsub_s(float a,float b){float r;asm("v_sub_f32_e32 %0, %1, %2":"=v"(r):"v"(a),"v"(b));return r;}
typedef float f32x2_t __attribute__((ext_vector_type(2))); typedef __bf16 bf16x2_t __attribute__((ext_vector_type(2)));
__device__ __forceinline__ unsigned cvtpk_s(float lo,float hi){f32x2_t v={lo,hi};bf16x2_t b=__builtin_convertvector(v,bf16x2_t);return __builtin_bit_cast(unsigned,b);}
#define WAIT_BAR(N) asm volatile("s_waitcnt vmcnt(" #N ") lgkmcnt(0)\n\ts_barrier":::"memory")

template<int ND0> __device__ __forceinline__ void qkt(f32x16&p0,f32x16&p1,const char*Kslot,const bf16x8*qr,const f32x16&negm,int r32,int hi){
  const char*kb=Kslot+hi*1024+r32*16;
  #pragma unroll
  for(int d0=0;d0<ND0;++d0){
    const bf16x8 b0=*reinterpret_cast<const bf16x8*>(kb+d0*2048);
    const bf16x8 b1=*reinterpret_cast<const bf16x8*>(kb+d0*2048+512);
    if(d0==0){p0=__builtin_amdgcn_mfma_f32_32x32x16_bf16(b0,qr[0],negm,0,0,0);p1=__builtin_amdgcn_mfma_f32_32x32x16_bf16(b1,qr[0],negm,0,0,0);}
    else{p0=__builtin_amdgcn_mfma_f32_32x32x16_bf16(b0,qr[d0],p0,0,0,0);p1=__builtin_amdgcn_mfma_f32_32x32x16_bf16(b1,qr[d0],p1,0,0,0);}}
}
typedef __attribute__((address_space(3))) const char* lds_cptr;
typedef short v4i16_t __attribute__((ext_vector_type(4)));
__device__ __forceinline__ void kload8(bf16x8*kf,lds_cptr kp){
  kf[0]=*(const __attribute__((address_space(3))) bf16x8*)(kp);      kf[1]=*(const __attribute__((address_space(3))) bf16x8*)(kp+512);
  kf[2]=*(const __attribute__((address_space(3))) bf16x8*)(kp+2048); kf[3]=*(const __attribute__((address_space(3))) bf16x8*)(kp+2560);
  kf[4]=*(const __attribute__((address_space(3))) bf16x8*)(kp+4096); kf[5]=*(const __attribute__((address_space(3))) bf16x8*)(kp+4608);
  kf[6]=*(const __attribute__((address_space(3))) bf16x8*)(kp+6144); kf[7]=*(const __attribute__((address_space(3))) bf16x8*)(kp+6656);
}
__device__ __forceinline__ void kload2(bf16x8*kf,lds_cptr kp,int j){ kf[2*j]=*(const __attribute__((address_space(3))) bf16x8*)(kp+j*2048); kf[2*j+1]=*(const __attribute__((address_space(3))) bf16x8*)(kp+j*2048+512); }
__device__ __forceinline__ s16x4 vtr(lds_cptr p){ return __builtin_bit_cast(s16x4,__builtin_amdgcn_ds_read_tr16_b64_v4i16((__attribute__((address_space(3))) v4i16_t*)p)); }
__device__ __forceinline__ float rowmax(const f32x16&p0,const f32x16&p1){
  float a=max3f(p0[0],p0[1],p1[0]),b=max3f(p0[2],p0[3],p1[1]);a=max3f(a,p1[2],p1[3]);
  #pragma unroll
  for(int r=4;r<16;r+=4){a=max3f(a,p0[r],p0[r+1]);b=max3f(b,p0[r+2],p0[r+3]);a=max3f(a,p1[r],p1[r+1]);b=max3f(b,p1[r+2],p1[r+3]);}
  const float m=max2f(a,b);
  auto rr=__builtin_amdgcn_permlane32_swap(__float_as_uint(m),__float_as_uint(m),false,false);
  return max2f(__uint_as_float(rr[0]),__uint_as_float(rr[1]));
}
__device__ __forceinline__ void pv(f32x16*o,int vb,bf16x8 pa0,bf16x8 pa1,bf16x8 pa2,bf16x8 pa3){
  #pragma unroll
  for(int d0=0;d0<2;++d0){s16x4 lo[4],hi[4];
    #pragma unroll
    for(int ks=0;ks<4;++ks){
      asm volatile("ds_read_b64_tr_b16 %0,%1 offset:%c2":"=&v"(lo[ks]):"v"(vb),"i"(d0*4096+ks*1024):"memory");
      asm volatile("ds_read_b64_tr_b16 %0,%1 offset:%c2":"=&v"(hi[ks]):"v"(vb),"i"(d0*4096+ks*1024+512):"memory");}
    asm volatile("s_waitcnt lgkmcnt(0)":::"memory");SBAR();
    #define PK(k) (bf16x8){lo[k][0],lo[k][1],lo[k][2],lo[k][3],hi[k][0],hi[k][1],hi[k][2],hi[k][3]}
    o[d0]=__builtin_amdgcn_mfma_f32_32x32x16_bf16(pa0,PK(0),o[d0],0,0,0);
    o[d0]=__builtin_amdgcn_mfma_f32_32x32x16_bf16(pa1,PK(1),o[d0],0,0,0);
    o[d0]=__builtin_amdgcn_mfma_f32_32x32x16_bf16(pa2,PK(2),o[d0],0,0,0);
    o[d0]=__builtin_amdgcn_mfma_f32_32x32x16_bf16(pa3,PK(3),o[d0],0,0,0);
    #undef PK
  }
}

#ifndef ATTN_STORE16
#define ATTN_STORE16(p,v) (*(u32x4*)(p)=(v))
#endif
template<int THRL,bool FIXREF,bool HALFK> __device__ __forceinline__ void attn_unit(float mref,long rowbase,int q0,const bf16*Qh,int PQ,const bf16*__restrict__ Kh_,int PK,const bf16*__restrict__ Vh_,int PV,bf16*Oh,int PO,const bf16*Gh,int PG,u32x4(&okeep)[4],int omode,float lam,float oml,const float*subln,char*shm){
  const int tid=fresh_tid(),lane=tid&63,r32=lane&31,hi=lane>>5; const int wid=__builtin_amdgcn_readfirstlane(tid>>6);
  const bf16*Qw=Qh+(rowbase+q0+wid*QBLK)*PQ;
  const bf16*Kh=Kh_+rowbase*PK,*Vh=Vh_+rowbase*PV;
  const unsigned lds0=(unsigned)(uintptr_t)shm;
  float*wsf=(float*)(shm+LDS_WS)+wid*64;
  const bf16*ksrc=Kh+(long)lane*PK+wid*8;
  const bf16*vsrc=Vh+(long)(16*(wid&3)+(lane>>2))*PV+(wid>>2)*32+(lane&3)*8;
  const unsigned kdst=lds0+LDS_K+wid*1024, vdst=lds0+LDS_V+wid*1024;
  #define DMA_K(t,slot) glds16(ksrc+(long)(t)*KVBLK*PK,(unsigned)__builtin_amdgcn_readfirstlane(kdst+(slot)))
  #define DMA_V(t,slot) glds16(vsrc+(long)(t)*KVBLK*PV,(unsigned)__builtin_amdgcn_readfirstlane(vdst+(slot)))
  const int vb0=(int)(lds0+LDS_V)+((lane>>4)&1)*32+(lane&3)*8+(4*hi+((lane&15)>>2))*64;
  const char*Kbase=shm+LDS_K; bf16x8 kf[8];
  const lds_cptr shm3=(lds_cptr)shm; const lds_cptr kp0=shm3+LDS_K+hi*1024+r32*16; const lds_cptr vp0=shm3+LDS_V+((lane>>4)&1)*32+(lane&3)*8+(4*hi+((lane&15)>>2))*64;
  constexpr int NT=SEQ/KVBLK;
  if(Gh){ const bf16*Gw=Gh+(rowbase+q0+wid*QBLK)*PG;
    #pragma unroll
    for(int i=0;i<4;++i) glds16(Gw+(long)(i*8+(lane>>3))*PG+(lane&7)*8,(unsigned)__builtin_amdgcn_readfirstlane(lds0+LDS_GST+wid*4096+i*1024)); }
  DMA_K(0,0);DMA_V(0,0);DMA_K(1,SLOTB);
  bf16x8 qr[4];
  #pragma unroll
  for(int d0=0;d0<4;++d0)qr[d0]=*reinterpret_cast<const bf16x8*>(&Qw[(long)r32*PQ+d0*16+hi*8]);
  float mhat=0.f,l_reg=0.f;f32x16 o[2];o[0]=f32x16{};o[1]=f32x16{};f32x16 negm=f32x16{};
  if constexpr(FIXREF){ mhat=mref; _Pragma("unroll") for(int r=0;r<16;++r)negm[r]=-mref; }
  asm volatile("":"+v"(negm));
  #define CMASK(P0,P1,t) do{}while(0)
  bool resc=false;
  #define START(P0,P1) do{ resc=false; \
    if constexpr(!FIXREF){ const float rm=rowmax(P0,P1); const float dl=rm; mhat=fadd_s(mhat,dl); \
      _Pragma("unroll") for(int r=0;r<16;++r){P0[r]=fsub_s(P0[r],dl);P1[r]=fsub_s(P1[r],dl);} \
      _Pragma("unroll") for(int r=0;r<16;++r)negm[r]=-mhat; asm volatile("":"+v"(negm)); } \
    _Pragma("unroll") for(int r=0;r<16;++r)P0[r]=__builtin_amdgcn_exp2f(P0[r]); }while(0)
  #define RESC() do{ if(!FIXREF&&resc){ asm volatile("s_waitcnt lgkmcnt(0)":::"memory"); \
      _Pragma("unroll") for(int d_=0;d_<2;++d_) _Pragma("unroll") for(int r=0;r<16;++r)o[d_][r]*=wsf[crow(r,hi)]; } }while(0)
  f32x16 pA0,pA1,pB0,pB1;
  int sl_prev=0,sl_cur=0,sl_next=SLOTB;
  #define ROT() do{sl_prev=sl_cur;sl_cur=sl_next;sl_next=(sl_next==(NSLOT-1)*SLOTB)?0:sl_next+SLOTB;}while(0)
  DMA_K(2,2*SLOTB);
  WAIT_BAR(3);
  qkt<HALFK?2:4>(pA0,pA1,Kbase,qr,negm,r32,hi);asm volatile("s_nop 15\n\ts_nop 7":"+v"(pA0),"+v"(pA1));CMASK(pA0,pA1,0);
  START(pA0,pA1);
  _Pragma("unroll") for(int r=0;r<16;++r)pA1[r]=__builtin_amdgcn_exp2f(pA1[r]);
  WAIT_BAR(0);
  DMA_K(3,0);DMA_V(1,SLOTB);
  ROT();
  if constexpr(HALFK){ kload2(kf,kp0+sl_cur,0); kload2(kf,kp0+sl_cur,1); } else kload8(kf,kp0+sl_cur);
  WAIT_BAR(2);
  s16x4 vlo[8],vhi[8]; u32x4 pw0,pw1,pw2,pw3;
  #define PKW(P,B) cvtpk_s(P[B],P[B+1])
  #define PAF(k) __builtin_bit_cast(bf16x8,pw##k)
  #define VFR(i) (bf16x8){vlo[i][0],vlo[i][1],vlo[i][2],vlo[i][3],vhi[i][0],vhi[i][1],vhi[i][2],vhi[i][3]}
  #define PIN(x) asm volatile("":"+v"(x))
  #define MX3(a,b,c) __builtin_fmaxf(__builtin_fmaxf((a),(b)),(c))
  #define GAPA(MF,A0,A1,A2,A3,W0,W1,PW) do{ MF; sacc+=A0; sacc+=A1; sacc+=A2; sacc+=A3; PIN(sacc); W0; W1; PIN(PW); SBAR(); }while(0)
  #define EX(v) __builtin_amdgcn_exp2f(v)
  #define GAPB(MF,X,B) do{ MF; X[B]=EX(X[B]); X[B+1]=EX(X[B+1]); X[B+2]=EX(X[B+2]); X[B+3]=EX(X[B+3]); PIN(X); SBAR(); }while(0)
  #define VRD(i) do{ vlo[i]=vtr(vp_+(((i)>>2)*4096+((i)&3)*1024)); vhi[i]=vtr(vp_+(((i)>>2)*4096+((i)&3)*1024+512)); }while(0)
  #define KRD(G,j) do{ if(G){ kload2(kf,kp0+sl_next,j); SBAR(); } }while(0)
  #define STEP(C0,C1,P0,P1,t,GK,GV,GL) do{ SBAR(); \
    const lds_cptr vp_=vp0+sl_prev; \
    VRD(0); SBAR(); float sacc=(P0[0]+P0[1]); \
    GAPA(C0=__builtin_amdgcn_mfma_f32_32x32x16_bf16(kf[0],qr[0],negm,0,0,0), P0[2],P0[3],P0[4],P0[5],     pw0[0]=PKW(P0,0), pw0[1]=PKW(P0,2), pw0); \
    VRD(4); SBAR(); GAPA(C1=__builtin_amdgcn_mfma_f32_32x32x16_bf16(kf[1],qr[0],negm,0,0,0), P0[6],P0[7],P0[8],P0[9],     pw0[2]=PKW(P0,4), pw0[3]=PKW(P0,6), pw0); \
    VRD(1); SBAR(); GAPA(C0=__builtin_amdgcn_mfma_f32_32x32x16_bf16(kf[2],qr[1],C0,0,0,0),   P0[10],P0[11],P0[12],P0[13], pw1[0]=PKW(P0,8), pw1[1]=PKW(P0,10), pw1); \
    VRD(5); SBAR(); GAPA(C1=__builtin_amdgcn_mfma_f32_32x32x16_bf16(kf[3],qr[1],C1,0,0,0),   P0[14],P0[15],P1[0],P1[1],   pw1[2]=PKW(P0,12),pw1[3]=PKW(P0,14), pw1); \
    VRD(2); SBAR(); GAPA(if constexpr(!HALFK) C0=__builtin_amdgcn_mfma_f32_32x32x16_bf16(kf[4],qr[2],C0,0,0,0),   P1[2],P1[3],P1[4],P1[5],     pw2[0]=PKW(P1,0), pw2[1]=PKW(P1,2), pw2); \
    VRD(6); SBAR(); GAPA(if constexpr(!HALFK) C1=__builtin_amdgcn_mfma_f32_32x32x16_bf16(kf[5],qr[2],C1,0,0,0),   P1[6],P1[7],P1[8],P1[9],     pw2[2]=PKW(P1,4), pw2[3]=PKW(P1,6), pw2); \
    VRD(3); SBAR(); GAPA(if constexpr(!HALFK) C0=__builtin_amdgcn_mfma_f32_32x32x16_bf16(kf[6],qr[3],C0,0,0,0),   P1[10],P1[11],P1[12],P1[13], pw3[0]=PKW(P1,8), pw3[1]=PKW(P1,10), pw3); \
    VRD(7); SBAR(); GAPA(if constexpr(!HALFK) C1=__builtin_amdgcn_mfma_f32_32x32x16_bf16(kf[7],qr[3],C1,0,0,0),   P1[14],P1[15],0.f,0.f,       pw3[2]=PKW(P1,12),pw3[3]=PKW(P1,14), pw3); \
    l_reg+=sacc; \
    if(GK){DMA_K((t)+3,sl_cur);} if(GV){DMA_V((t)+1,sl_next);} \
    CMASK(C0,C1,t); \
    if constexpr(!FIXREF){ float a=MX3(C0[0],C0[1],C1[0]),b=MX3(C0[2],C0[3],C1[1]); a=MX3(a,C1[2],C1[3]); \
      _Pragma("unroll") for(int r=4;r<16;r+=4){a=MX3(a,C0[r],C0[r+1]);b=MX3(b,C0[r+2],C0[r+3]);a=MX3(a,C1[r],C1[r+1]);b=MX3(b,C1[r+2],C1[r+3]);} \
      float rm=__builtin_fmaxf(a,b); { auto rr=__builtin_amdgcn_permlane32_swap(__float_as_uint(rm),__float_as_uint(rm),false,false); rm=__builtin_fmaxf(__uint_as_float(rr[0]),__uint_as_float(rr[1])); } \
      resc=false; \
      if(__builtin_expect(__any(rm>(float)THRL),0)){ const float dl=__builtin_fmaxf(rm,0.f); mhat+=dl; \
        _Pragma("unroll") for(int r=0;r<16;++r){C0[r]-=dl;C1[r]-=dl;} \
        _Pragma("unroll") for(int r=0;r<16;++r)negm[r]=-mhat; asm volatile("":"+v"(negm)); \
        const float f=__builtin_amdgcn_exp2f(-dl); l_reg*=f; if(hi==0)wsf[r32]=f; resc=true; } } \
    SBAR(); \
    GAPB(o[0]=__builtin_amdgcn_mfma_f32_32x32x16_bf16(PAF(0),VFR(0),o[0],0,0,0), C0,0); \
    GAPB(o[1]=__builtin_amdgcn_mfma_f32_32x32x16_bf16(PAF(0),VFR(4),o[1],0,0,0), C0,4); \
    KRD(GL,0); GAPB(o[0]=__builtin_amdgcn_mfma_f32_32x32x16_bf16(PAF(1),VFR(1),o[0],0,0,0), C0,8); \
    KRD(GL,1); GAPB(o[1]=__builtin_amdgcn_mfma_f32_32x32x16_bf16(PAF(1),VFR(5),o[1],0,0,0), C0,12); \
    KRD((GL)&&!HALFK,2); GAPB(o[0]=__builtin_amdgcn_mfma_f32_32x32x16_bf16(PAF(2),VFR(2),o[0],0,0,0), C1,0); \
    KRD((GL)&&!HALFK,3); GAPB(o[1]=__builtin_amdgcn_mfma_f32_32x32x16_bf16(PAF(2),VFR(6),o[1],0,0,0), C1,4); \
    GAPB(o[0]=__builtin_amdgcn_mfma_f32_32x32x16_bf16(PAF(3),VFR(3),o[0],0,0,0), C1,8); \
    GAPB(o[1]=__builtin_amdgcn_mfma_f32_32x32x16_bf16(PAF(3),VFR(7),o[1],0,0,0), C1,12); \
    }while(0)
  int t=1;
  #undef CMASK
  #define CMASK(P0,P1,t) do{}while(0)
  for(;t+5<NT;t+=2){
    STEP(pB0,pB1,pA0,pA1,t,true,true,true);     WAIT_BAR(2); RESC(); ROT();
    STEP(pA0,pA1,pB0,pB1,t+1,true,true,true);   WAIT_BAR(2); RESC(); ROT();
  }
  #undef CMASK
  #define CMASK(P0,P1,t) do{}while(0)
  #define ENDW(tt) do{ if((tt)+3<NT){WAIT_BAR(2);} else if((tt)+2<NT){WAIT_BAR(1);} else {WAIT_BAR(0);} }while(0)
  for(;t+1<NT;t+=2){
    STEP(pB0,pB1,pA0,pA1,t,(t+3<NT),(t+1<NT),(t+1<NT));       ENDW(t);   RESC(); ROT();
    STEP(pA0,pA1,pB0,pB1,t+1,(t+4<NT),(t+2<NT),(t+2<NT));     ENDW(t+1); RESC(); ROT();
  }
  STEP(pB0,pB1,pA0,pA1,NT-1,false,false,false); RESC();
  { float sacc=pB0[0]+pB0[1]; _Pragma("unroll") for(int r=2;r<16;++r)sacc+=pB0[r]; _Pragma("unroll") for(int r=0;r<16;++r)sacc+=pB1[r]; l_reg+=sacc;
    pw0=(u32x4){PKW(pB0,0),PKW(pB0,2),PKW(pB0,4),PKW(pB0,6)};pw1=(u32x4){PKW(pB0,8),PKW(pB0,10),PKW(pB0,12),PKW(pB0,14)};pw2=(u32x4){PKW(pB1,0),PKW(pB1,2),PKW(pB1,4),PKW(pB1,6)};pw3=(u32x4){PKW(pB1,8),PKW(pB1,10),PKW(pB1,12),PKW(pB1,14)};
    SBAR(); pv(o,vb0+sl_cur,PAF(0),PAF(1),PAF(2),PAF(3)); }
  #undef PKW
  #undef PAF
  #undef VFR
  #undef PIN
  #undef MX3
  #undef GAPA
  #undef GAPB
  #undef EX
  #undef VRD
  #undef KRD
  #undef STEP
  #undef ENDW
  {auto rr=__builtin_amdgcn_permlane32_swap(__float_as_uint(l_reg),__float_as_uint(l_reg),false,false);l_reg=__uint_as_float(rr[0])+__uint_as_float(rr[1]);}
  if(hi==0)wsf[32+r32]=l_reg;asm volatile("s_waitcnt lgkmcnt(0)":::"memory");
  float rli[16];
  #pragma unroll
  for(int r=0;r<16;++r)rli[r]=__builtin_amdgcn_rcpf(wsf[32+crow(r,hi)]);
  bf16*Ow=Oh+(rowbase+q0+wid*QBLK)*PO;
  { bf16*stg=(bf16*)(shm+LDS_OST)+wid*2048;
    #pragma unroll
    for(int r=0;r<16;++r){const int orow=crow(r,hi);
      #pragma unroll
      for(int d0=0;d0<2;++d0)stg[orow*64+d0*32+r32]=__float2bfloat16(o[d0][r]*rli[r]);}
    asm volatile("s_waitcnt lgkmcnt(0)":::"memory");
    if(omode==2){
      u32x4 gv[4]; const char*gst=shm+LDS_GST+wid*4096+lane*16;
      #pragma unroll
      for(int i=0;i<4;++i) gv[i]=*(const u32x4*)(gst+i*1024);
      float sg[8]; { const int ch=lane&7;
        #pragma unroll
        for(int e=0;e<8;++e)sg[e]=subln[ch*8+e]*oml; }
      #pragma unroll
      for(int i=0;i<4;++i){const int row=i*8+(lane>>3),ch=lane&7; u32x4 v=*(const u32x4*)(stg+row*64+ch*8); float d[8]; float ss=0.f;
        #pragma unroll
        for(int k=0;k<4;++k){ d[2*k]=__uint_as_float(okeep[i][k]<<16)-lam*__uint_as_float(v[k]<<16); d[2*k+1]=__uint_as_float(okeep[i][k]&0xffff0000u)-lam*__uint_as_float(v[k]&0xffff0000u); ss+=d[2*k]*d[2*k]+d[2*k+1]*d[2*k+1]; }
        ss+=__shfl_xor(ss,1); ss+=__shfl_xor(ss,2); ss+=__shfl_xor(ss,4);
        const float rstd=rsqrtf(ss*(1.f/64.f)+1e-6f);
        #pragma unroll
        for(int k=0;k<4;++k){ const float g0=__uint_as_float(gv[i][k]<<16),g1=__uint_as_float(gv[i][k]&0xffff0000u);
          v[k]=cvtpk_s(d[2*k]*rstd*sg[2*k]*g0*__builtin_amdgcn_rcpf(1.f+__builtin_amdgcn_exp2f(-1.4426950408889634f*g0)),d[2*k+1]*rstd*sg[2*k+1]*g1*__builtin_amdgcn_rcpf(1.f+__builtin_amdgcn_exp2f(-1.4426950408889634f*g1))); }
        ATTN_STORE16(Ow+(long)row*PO+ch*8,v);} }
    else if(Gh){
      u32x4 gv[4]; const char*gst=shm+LDS_GST+wid*4096+lane*16;
      #pragma unroll
      for(int i=0;i<4;++i) gv[i]=*(const u32x4*)(gst+i*1024);
      #pragma unroll
      for(int i=0;i<4;++i){const int row=i*8+(lane>>3),ch=lane&7; u32x4 v=*(const u32x4*)(stg+row*64+ch*8);
        #pragma unroll
        for(int k=0;k<4;++k){ const float g0=__uint_as_float(gv[i][k]<<16),g1=__uint_as_float(gv[i][k]&0xffff0000u),o0=__uint_as_float(v[k]<<16),o1=__uint_as_float(v[k]&0xffff0000u);
          v[k]=cvtpk_s(o0*g0*__builtin_amdgcn_rcpf(1.f+__builtin_amdgcn_exp2f(-1.4426950408889634f*g0)),o1*g1*__builtin_amdgcn_rcpf(1.f+__builtin_amdgcn_exp2f(-1.4426950408889634f*g1))); }
        ATTN_STORE16(Ow+(long)row*PO+ch*8,v);} }
    else if(omode==1){
    #pragma unroll
    for(int i=0;i<4;++i){const int row=i*8+(lane>>3),ch=lane&7; okeep[i]=*(const u32x4*)(stg+row*64+ch*8);} }
    else{
    #pragma unroll
    for(int i=0;i<4;++i){const int row=i*8+(lane>>3),ch=lane&7; const u32x4 v=*(const u32x4*)(stg+row*64+ch*8); ATTN_STORE16(Ow+(long)row*PO+ch*8,v);} } }
  asm volatile("s_waitcnt lgkmcnt(0)\n\ts_barrier":::"memory");
  #undef DMA_K
  #undef DMA_V
  #undef CMASK
  #undef START
  #undef RESC
  #undef ROT
}
constexpr int ATTN_LDS_BYTES=LDS_BYTES+NW*4096;
#undef SBAR
#undef WAIT_BAR
}
namespace cg = cooperative_groups;
#define GAS __attribute__((address_space(1)))
#define LAS __attribute__((address_space(3)))
typedef unsigned short bf16r;
typedef unsigned v4u __attribute__((ext_vector_type(4)));
typedef unsigned v2u __attribute__((ext_vector_type(2)));
typedef float f32x4 __attribute__((ext_vector_type(4)));
typedef float f32x16 __attribute__((ext_vector_type(16)));
typedef short bf16x8 __attribute__((ext_vector_type(8)));

constexpr int NWAVES = 8, NTHR = 512;
constexpr int BATCH = 8, SEQ = 4096, DMODEL = 1024, DIN = 3840, MROWS = BATCH * SEQ, DEPTH = 2;
constexpr float EPS = 1e-6f;
constexpr int C_AQ = 0, C_AK = 256, C_AV = 384, C_AG = 512, C_BP = 768, C_BG = 1536, C_CQ = 1792, C_CK = 2048, C_CV = 2304, C_CG = 2560, C_DP = 2816, C_DG = 3584;
constexpr size_t MiB = 1u << 20;
constexpr size_t WS_CTL = 0, CTL_ZERO_BYTES = 1 * MiB;
constexpr size_t WS_MOD = 0;
constexpr size_t WS_NORM = 256 * 1024;
constexpr size_t WS_BAR = 512 * 1024;
constexpr int MISC_OFF = 131072 + 320;
constexpr size_t WS_TABSEQ = 1 * MiB;
constexpr size_t WS_TABRC = 1 * MiB + 512 * 1024;
constexpr size_t WS_RG = 2 * MiB;
constexpr size_t WS_WIN = 10 * MiB;
constexpr size_t WS_WOUT = 25 * MiB;
constexpr size_t WS_H = 32 * MiB;
constexpr size_t WS_PROJ = 96 * MiB;
constexpr size_t WS_QA = 336 * MiB;
constexpr size_t WS_KA = 352 * MiB;
constexpr size_t WS_QC = 360 * MiB;
constexpr size_t WS_KC = 392 * MiB;
constexpr size_t WS_ZT = 424 * MiB;
constexpr size_t WS_YT = 440 * MiB;
constexpr size_t WS_OA = 456 * MiB;
constexpr size_t WS_OC = 472 * MiB;
constexpr size_t WS_DELTA = WS_QA;
constexpr size_t WS_RG1 = 504 * MiB;
constexpr size_t WS_END = 512 * MiB;
constexpr int LDS_BYTES = 147456;

struct Params { const float* in[26]; float* out; unsigned char* ws; float inv[16]; float lam_init[2]; int pad[2]; };

typedef const __attribute__((address_space(4))) Params* KParams;
__device__ __forceinline__ KParams fresh_params() { KParams kp = (KParams)__builtin_amdgcn_kernarg_segment_ptr(); asm volatile("" : "+s"(kp)); return kp; }
__device__ __forceinline__ unsigned f2bf(float f) { unsigned u = __builtin_bit_cast(unsigned, f); return (u + 0x7fffu + ((u >> 16) & 1u)) >> 16; }
__device__ __forceinline__ unsigned pk2(float lo, float hi) { return f2bf(lo) | (f2bf(hi) << 16); }
__device__ __forceinline__ float bflo(unsigned w) { return __builtin_bit_cast(float, w << 16); }
__device__ __forceinline__ float bfhi(unsigned w) { return __builtin_bit_cast(float, w & 0xffff0000u); }
__device__ __forceinline__ float bf1(bf16r h) { return __builtin_bit_cast(float, (unsigned)h << 16); }
__device__ __forceinline__ float silu_f(float v) { return v * __builtin_amdgcn_rcpf(1.f + __builtin_amdgcn_exp2f(-1.4426950408889634f * v)); }
#define LDS_WAIT() asm volatile("s_waitcnt lgkmcnt(0)" ::: "memory")
__device__ __forceinline__ float shx(float v, int mask, int lane) { return __builtin_bit_cast(float, __builtin_amdgcn_ds_bpermute((lane ^ mask) << 2, __builtin_bit_cast(int, v))); }

__host__ __device__ __forceinline__ int win_l2p(int l) { return (int)((0xedca96b85741032ULL >> (4 * l)) & 15); }
__host__ __device__ __forceinline__ int win_p2l(int p) { return (int)((0xedc8ba759641032ULL >> (4 * p)) & 15); }
__device__ __forceinline__ int win_row_remap(int n0) {
    if (n0 < 256) { const int h = n0 >> 6, bj = (n0 >> 5) & 1; return 128 * bj + 32 * h; }
    if (n0 < 384) { const int q = n0 - 256, h = q >> 6, bj = (q >> 5) & 1; return 256 + 128 * bj + 32 * h; }
    if (n0 < 512) { const int j = n0 - 384; return j < 64 ? 256 + 64 + j : 256 + 192 + (j - 64); }
    if (n0 >= 2816) {
        const int q = n0 - 2816, a = q >> 8, cc = q & 255, h = cc >> 7, off = cc & 127;
        const int tile = (a == 0 || a == 3) ? 11 + h : 13 + h, bj = (a == 0 || a == 1) ? 0 : 1;
        return 256 * tile + 128 * bj + off; }
    return n0; }
__device__ __forceinline__ bool win_block_plain(int n0) { return !(n0 < 384 || (n0 >= 1024 && n0 < 1536) || (n0 >= 1792 && n0 < 2304)); }
template <bool REMAP> __device__ __forceinline__ void p0_transpose_item(const float* W, int K, int N, bf16r* WT, LAS float* scr, int item, int lane) {
    const int nblk = N / 32, kb = item / nblk, nb = item % nblk, k0 = 64 * kb, n0 = 32 * nb, rl = REMAP ? win_row_remap(n0) : n0, r0 = REMAP ? 256 * win_l2p(rl >> 8) + (rl & 255) : n0;
    const bool slot = REMAP && win_block_plain(n0);
#pragma unroll 8
    for (int i = 0; i < 32; ++i) { const int kk = 2 * i + (lane >> 5); scr[kk * 33 + (lane & 31)] = W[(size_t)(k0 + kk) * N + n0 + (lane & 31)]; }
    LDS_WAIT(); asm volatile("" ::: "memory");
    const int c = lane & 7;
#pragma unroll
    for (int j = 0; j < 4; ++j) { const int n = (lane >> 3) + 8 * j; const LAS float* s = scr + (8 * c) * 33 + n;
        v4u o; o.x = pk2(s[0 * 33], s[1 * 33]); o.y = pk2(s[2 * 33], s[3 * 33]); o.z = pk2(s[4 * 33], s[5 * 33]); o.w = pk2(s[6 * 33], s[7 * 33]);
        const int rn = slot ? (16 * ((n >> 2) & 1) + 4 * (n >> 3) + (n & 3)) : n;
        *(v4u*)(WT + (size_t)(r0 + rn) * K + k0 + 8 * c) = o; }
    LDS_WAIT(); asm volatile("" ::: "memory");
}

__device__ __forceinline__ void phase_prologue(LAS unsigned char* lds, int vcu, int G, bool first) {
    const int tid = fresh_tid(), lane = tid & 63, wave = __builtin_amdgcn_readfirstlane(tid >> 6);
    const KParams P = fresh_params(); unsigned char* ws = P->ws;
    {
        LAS float* scr = (LAS float*)(lds + wave * 16384);
        const int gw = vcu * NWAVES + wave, NGW = G * NWAVES;
        constexpr int I_IN = (DMODEL / 64) * (DIN / 32), I_OUT = (DMODEL / 64) * (DMODEL / 32);
        constexpr int NITEMS = DEPTH * (I_IN + I_OUT);
        for (int it = gw; it < NITEMS; it += NGW) {
            int l = it / (I_IN + I_OUT), r = it % (I_IN + I_OUT);
            if (r < I_IN) p0_transpose_item<true>(P->in[5] + (size_t)l * DMODEL * DIN, DMODEL, DIN, (bf16r*)(ws + WS_WIN) + (size_t)l * DIN * DMODEL, scr, r, lane);
            else p0_transpose_item<false>(P->in[6] + (size_t)l * DMODEL * DMODEL, DMODEL, DMODEL, (bf16r*)(ws + WS_WOUT) + (size_t)l * DMODEL * DMODEL, scr, r - I_IN, lane);
        }
    }
    __syncthreads();
    LAS float* L = (LAS float*)lds;
    for (int it = blockIdx.x; it < 192 + 256; it += G) {
        if (it < 192) {
            const int l = it / 96, r = it % 96, cb = r / 16, kc = r % 16;
            { const int b = tid >> 6, kk = tid & 63; L[b * 64 + kk] = silu_f(P->in[1][b * DMODEL + kc * 64 + kk]); }
            __syncthreads();
            const int j = cb * 512 + tid;
            const float* w = P->in[3] + (size_t)l * DMODEL * 3072 + (size_t)(kc * 64) * 3072 + j;
            float acc[8];
#pragma unroll
            for (int b = 0; b < 8; ++b) acc[b] = 0.f;
#pragma unroll 16
            for (int kk = 0; kk < 64; ++kk) { const float wv = w[(size_t)kk * 3072];
#pragma unroll
                for (int b = 0; b < 8; ++b) acc[b] += L[b * 64 + kk] * wv; }
            const float bb = (kc == 0) ? P->in[4][l * 3072 + j] : 0.f;
            float* mod = (float*)(ws + WS_MOD) + (size_t)l * 8 * 3072 + j;
#pragma unroll
            for (int b = 0; b < 8; ++b) atomicAdd(mod + b * 3072, first ? acc[b] + bb : 0.f);
            __syncthreads();
        } else {
            const int q = it - 192, l = q / 128, t0 = (q % 128) * 32;
            LAS float* emb = L;
            LAS float* h1 = L + 32 * 33;
            LAS float* h2 = h1 + 32 * 64;
            for (int idx = tid; idx < 32 * 33; idx += NTHR) {
                const int p = idx / 33, k = idx % 33; const float t = (float)(t0 + p);
                const float w = (6.2831855f * t) * (1.0f / 4096.0f);
                float v;
                if (k == 0) v = t / 4095.0f;
                else { const int i = (k - 1) & 15; const float fk = 1e-4f + (float)i * ((15.0f - 1e-4f) / 15.0f); const float a = fk * w; v = (k <= 16) ? cosf(a) : -sinf(a); }
                emb[idx] = v;
            }
            __syncthreads();
            const float* w1 = P->in[11] + l * 33 * 64; const float* b1 = P->in[12] + l * 64; const float* fr = P->in[13] + l * 64;
            const float* w2 = P->in[14] + l * 64 * 64; const float* b2 = P->in[15] + l * 64; const float* w3 = P->in[16] + l * 64 * 512;
            {
                const int j = tid & 63, pb = tid >> 6; const float frj = fr[j];
                { float wc[33];
#pragma unroll
                  for (int k = 0; k < 33; ++k) wc[k] = w1[k * 64 + j];
                  const float bj = b1[j];
#pragma unroll 1
                  for (int e = 0; e < 4; ++e) { const int p = pb + 8 * e; float v = bj;
#pragma unroll
                      for (int k = 0; k < 33; ++k) v += emb[p * 33 + k] * wc[k];
                      h1[p * 64 + j] = sinf(frj * v); } }
                __syncthreads();
                { float wc[64];
#pragma unroll
                  for (int k = 0; k < 64; ++k) wc[k] = w2[k * 64 + j];
                  const float bj = b2[j];
#pragma unroll 1
                  for (int e = 0; e < 4; ++e) { const int p = pb + 8 * e; float v = bj;
#pragma unroll
                      for (int k = 0; k < 64; ++k) v += h1[p * 64 + k] * wc[k];
                      h2[p * 64 + j] = sinf(frj * v); } }
                __syncthreads();
            }
            {
                const int ch = tid, c = ch & 255, isb = ch >> 8;
                const float absd = 3.0701134573253945f + (float)c * ((15.350567286626972f - 3.0701134573253945f) / 255.0f);
                bf16r* rg = (bf16r*)(ws + WS_RG) + ((size_t)l * 256 + c) * 8192; bf16r* rg1 = (bf16r*)(ws + WS_RG1) + ((size_t)l * 256 + c) * 8192;
                float nsum = 0.f; float w3c[64];
#pragma unroll
                for (int k = 0; k < 64; ++k) w3c[k] = w3[k * 512 + ch];
#pragma unroll 1
                for (int p = 0; p < 32; ++p) {
                    float o = 0.f;
#pragma unroll
                    for (int k = 0; k < 64; ++k) o += h2[p * 64 + k] * w3c[k];
                    const int t = t0 + p; const float tl = (float)t / 4095.0f;
                    const float v = o * (__expf(-tl * absd) + 0.05f);
                    if (!isb) { rg[4096 - t] = (bf16r)f2bf(v); rg1[4095 - t] = (bf16r)f2bf(v); nsum += fabsf(v); }
                    else if (t > 0) { rg[4096 + t] = (bf16r)f2bf(v); rg1[4095 + t] = (bf16r)f2bf(v); nsum += fabsf(v); }
                }
                if (t0 == 0 && !isb) { rg[0] = 0; rg1[8191] = 0; }
                atomicAdd((float*)(ws + WS_NORM) + l * 256 + c, first ? nsum : 0.f);
            }
            __syncthreads();
        }
    }
    {
        float2* tseq = (float2*)(ws + WS_TABSEQ); float2* trc = (float2*)(ws + WS_TABRC);
        for (int idx = blockIdx.x * NTHR + tid; idx < 4096 * 16 + 64 * 16; idx += G * NTHR) {
            const int e = idx < 65536 ? idx : idx - 65536; const int pos = e >> 4, i = e & 15;
            const float a = (float)pos * P->inv[i];
            const float2 cs = make_float2(cosf(a), sinf(a));
            if (idx < 65536) tseq[e] = cs; else trc[e] = cs;
        }
    }
}

__host__ __device__ __forceinline__ int d0_col(int c) { return c < 384 ? c : c < 896 ? c + 640 : c + 896; }
__device__ __forceinline__ void phase_norm(int l, int vcu, int G) {
    const int tid = fresh_tid(), lane = tid & 63, wave = __builtin_amdgcn_readfirstlane(tid >> 6);
    const KParams P = fresh_params(); unsigned char* ws = P->ws; bf16r* H = (bf16r*)(ws + WS_H);
    const float* xin = P->in[0]; const bf16r* DL = (const bf16r*)(ws + WS_PROJ);
    const float* g = P->in[2] + l * DMODEL; const float* mod = (const float*)(ws + WS_MOD) + (size_t)l * 8 * 3072;
    const int gw = vcu * NWAVES + wave, NGW = G * NWAVES;
    for (int m = gw; m < MROWS; m += NGW) {
        const float* xr = xin + (size_t)m * DMODEL + 8 * lane;
        f32x4 v[2][2]; float s = 0.f;
#pragma unroll
        for (int j = 0; j < 2; ++j) { v[j][0] = *(const f32x4*)(xr + 512 * j); v[j][1] = *(const f32x4*)(xr + 512 * j + 4); }
        if (l > 0) {
            const bf16r* dr = DL + (size_t)m * DIN;
#pragma unroll
            for (int j = 0; j < 2; ++j) { const v4u d = *(const v4u*)(dr + d0_col(512 * j + 8 * lane));
                v[j][0].x += bflo(d.x); v[j][0].y += bfhi(d.x); v[j][0].z += bflo(d.y); v[j][0].w += bfhi(d.y); v[j][1].x += bflo(d.z); v[j][1].y += bfhi(d.z); v[j][1].z += bflo(d.w); v[j][1].w += bfhi(d.w); }
        }
#pragma unroll
        for (int j = 0; j < 2; ++j)
#pragma unroll
            for (int h = 0; h < 2; ++h) s += (v[j][h].x * v[j][h].x + v[j][h].y * v[j][h].y) + (v[j][h].z * v[j][h].z + v[j][h].w * v[j][h].w);
#pragma unroll
        for (int o = 1; o < 64; o <<= 1) s += shx(s, o, lane);
        const float rstd = rsqrtf(s * (1.f / DMODEL) + EPS);
        const float* mb = mod + (m >> 12) * 3072;
#pragma unroll
        for (int j = 0; j < 2; ++j) { const int col = 512 * j + 8 * lane; f32x4 hh[2];
#pragma unroll
            for (int h = 0; h < 2; ++h) { const f32x4 gg = *(const f32x4*)(g + col + 4 * h), sh = *(const f32x4*)(mb + col + 4 * h), sc = *(const f32x4*)(mb + 1024 + col + 4 * h);
                hh[h] = v[j][h] * rstd * gg * (sc + 1.0f) + sh; }
            v4u o; o.x = pk2(hh[0].x, hh[0].y); o.y = pk2(hh[0].z, hh[0].w); o.z = pk2(hh[1].x, hh[1].y); o.w = pk2(hh[1].z, hh[1].w);
            *(v4u*)(H + (size_t)m * DMODEL + col) = o; }
    }
}

__device__ __forceinline__ void unpack8(const v4u w, float (&f)[8]) {
    f[0] = bflo(w.x); f[1] = bfhi(w.x); f[2] = bflo(w.y); f[3] = bfhi(w.y); f[4] = bflo(w.z); f[5] = bfhi(w.z); f[6] = bflo(w.w); f[7] = bfhi(w.w); }
__device__ __forceinline__ v4u pack8(const float (&f)[8]) { v4u o; o.x = pk2(f[0], f[1]); o.y = pk2(f[2], f[3]); o.z = pk2(f[4], f[5]); o.w = pk2(f[6], f[7]); return o; }
constexpr int YTP = 66;
template <int VPL, int HD, bool AXIAL>
__device__ __forceinline__ void qk_norm_rope(float (&v)[VPL], int lane, const float* gain, const float2* tseq_or_row, const float2* tcol, float outscale) {
    const int d0 = (lane * VPL) % HD;
    float ss = 0.f;
#pragma unroll
    for (int e = 0; e < VPL; ++e) ss += v[e] * v[e];
#pragma unroll
    for (int o = 1; o < HD / VPL; o <<= 1) ss += __shfl_xor(ss, o);
    const float rstd = rsqrtf(ss * (1.f / HD) + EPS);
    const int db = d0 & 31; const bool x2 = db >= 16; const int i0 = db & 15;
    const float2* tab = (AXIAL && (d0 & 32)) ? tcol : tseq_or_row;
#pragma unroll
    for (int e = 0; e < VPL; ++e) {
        const float y = v[e] * rstd * gain[d0 + e];
        const float pr = __shfl_xor(y, 16 / VPL);
        const float2 cs = tab[i0 + e];
        v[e] = (x2 ? (y * cs.x + pr * cs.y) : (y * cs.x - pr * cs.y)) * outscale;
    }
}

__device__ __forceinline__ void phase_prep(int l, LAS unsigned char* lds, int G) {
    const int tid = fresh_tid(), lane = tid & 63, wave = __builtin_amdgcn_readfirstlane(tid >> 6);
    const KParams P = fresh_params(); unsigned char* ws = P->ws;
    const bf16r* PROJ = (const bf16r*)(ws + WS_PROJ);
    bf16r* QA = (bf16r*)(ws + WS_QA); bf16r* KA = (bf16r*)(ws + WS_KA); bf16r* QC = (bf16r*)(ws + WS_QC); bf16r* KC = (bf16r*)(ws + WS_KC); bf16r* ZT = (bf16r*)(ws + WS_ZT);
    const float2* tseq = (const float2*)(ws + WS_TABSEQ); const float2* trc = (const float2*)(ws + WS_TABRC);
    const float* aqn = P->in[7] + l * 64; const float* akn = P->in[8] + l * 64; const float* cqn = P->in[18] + l * 32; const float* ckn = P->in[19] + l * 32;
    const float* cw = P->in[9] + l * 3 * 768; const float* cbv = P->in[10] + l * 768;
    constexpr float L2E = 1.4426950408889634f;
    LAS bf16r* zt = (LAS bf16r*)lds;
    for (int tile = blockIdx.x; tile < MROWS / 64; tile += G) {
        const int b = tile >> 6, t0 = (tile & 63) * 64; const size_t row0 = (size_t)tile * 64;
        {
            const int c8 = tid & 31, rgp = tid >> 5, c = 8 * c8, tl0 = 4 * rgp, tb = t0 + tl0;
            const bf16r* base = PROJ + (row0 + tl0) * DIN + C_BP + c;
            v4u xw[6], vw[6];
#pragma unroll
            for (int q = 0; q < 6; ++q) { const int t = tb + q - 1; const bool ok = (t >= 0) && (t < SEQ);
                v4u a = (v4u){0u, 0u, 0u, 0u}, d = a;
                if (ok) { const bf16r* pr = base + (long)(q - 1) * DIN; a = *(const v4u*)(pr + 256); d = *(const v4u*)(pr + 512); }
                xw[q] = a; vw[q] = d; }
#pragma unroll
            for (int r = 0; r < 4; ++r) { float xa[8], xb[8], xc[8], va[8], vb[8], vc[8];
                unpack8(xw[r], xa); unpack8(xw[r + 1], xb); unpack8(xw[r + 2], xc); unpack8(vw[r], va); unpack8(vw[r + 1], vb); unpack8(vw[r + 2], vc);
#pragma unroll
                for (int e = 0; e < 8; ++e) {
                    const float x1 = cw[256 + c + e] * xa[e] + cw[768 + 256 + c + e] * xb[e] + cw[1536 + 256 + c + e] * xc[e] + cbv[256 + c + e];
                    const float v1 = cw[512 + c + e] * va[e] + cw[768 + 512 + c + e] * vb[e] + cw[1536 + 512 + c + e] * vc[e] + cbv[512 + c + e];
                    zt[(c + e) * YTP + tl0 + r] = (bf16r)f2bf(x1 * v1); } }
        }
        __syncthreads();
#pragma unroll 4
        for (int i = 0; i < 16; ++i) { const int c = 32 * wave + 2 * i + (lane >> 5), tl = 2 * (lane & 31);
            const unsigned w = *(const LAS unsigned*)(zt + c * YTP + tl);
            *(unsigned*)(ZT + ((size_t)c * BATCH + b) * SEQ + t0 + tl) = w; }
        __syncthreads();
    }
}

__device__ __forceinline__ int crow_(int r, int hi) { return (r & 3) + 8 * (r >> 2) + 4 * hi; }
constexpr int RG1_LDS = 16384 + 64;
constexpr int ZPITCH = 8208;
__device__ __forceinline__ void phase_hyena(int l, LAS unsigned char* lds, int G) {
    const int tid = fresh_tid(), lane = tid & 63, wave = __builtin_amdgcn_readfirstlane(tid >> 6);
    const KParams P = fresh_params(); unsigned char* ws = P->ws;
    const bf16r* X1T = (const bf16r*)(ws + WS_ZT); const bf16r* VT = (const bf16r*)(ws + WS_OA); bf16r* YT = (bf16r*)(ws + WS_YT);
    const float* cw = P->in[9] + l * 3 * 768; const float* cbv = P->in[10] + l * 768;
    const bf16r* RG = (const bf16r*)(ws + WS_RG) + (size_t)l * 256 * 8192; const bf16r* RG1 = (const bf16r*)(ws + WS_RG1) + (size_t)l * 256 * 8192;
    const float* NORM = (const float*)(ws + WS_NORM) + l * 256; const float* hb = P->in[17] + l * 256;
    LAS unsigned char* Zs = lds; LAS bf16r* rl = (LAS bf16r*)(lds + 8 * ZPITCH);
    const int r32 = lane & 31, hi = lane >> 5;
    for (int c = blockIdx.x; c < 256; c += G) {
        {
            const float wx0 = cw[256 + c], wx1 = cw[768 + 256 + c], wx2 = cw[1536 + 256 + c], bx = cbv[256 + c];
            const float wv0 = cw[512 + c], wv1 = cw[768 + 512 + c], wv2 = cw[1536 + 512 + c], bv = cbv[512 + c];
#pragma unroll
            for (int b = 0; b < 8; ++b) { const bf16r* xr = X1T + ((size_t)c * BATCH + b) * SEQ + tid * 8; const bf16r* vr = VT + ((size_t)c * BATCH + b) * SEQ + tid * 8;
                float xf[10], vf[10]; { float t8[8]; unpack8(*(const v4u*)xr, t8);
#pragma unroll
                    for (int e = 0; e < 8; ++e) xf[e + 1] = t8[e]; unpack8(*(const v4u*)vr, t8);
#pragma unroll
                    for (int e = 0; e < 8; ++e) vf[e + 1] = t8[e]; }
                xf[0] = tid > 0 ? bf1(xr[-1]) : 0.f; vf[0] = tid > 0 ? bf1(vr[-1]) : 0.f; xf[9] = tid < NTHR - 1 ? bf1(xr[8]) : 0.f; vf[9] = tid < NTHR - 1 ? bf1(vr[8]) : 0.f;
                float z[8];
#pragma unroll
                for (int e = 0; e < 8; ++e) z[e] = (wx0 * xf[e] + wx1 * xf[e + 1] + wx2 * xf[e + 2] + bx) * (wv0 * vf[e] + wv1 * vf[e + 1] + wv2 * vf[e + 2] + bv);
                *(LAS v4u*)(Zs + b * ZPITCH + tid * 16) = pack8(z); }
        }
#pragma unroll
        for (int i = 0; i < 2; ++i) { *(LAS v4u*)((LAS unsigned char*)rl + (i * NTHR + tid) * 16) = *(const v4u*)(RG + (size_t)c * 8192 + (i * NTHR + tid) * 8);
            *(LAS v4u*)((LAS unsigned char*)rl + RG1_LDS + (i * NTHR + tid) * 16) = *(const v4u*)(RG1 + (size_t)c * 8192 + (i * NTHR + tid) * 8); }
        __syncthreads();
        const float invn = 1.0f / NORM[c], bias = hb[c];
        f32x16 acc[2][2];
#pragma unroll
        for (int a = 0; a < 2; ++a)
#pragma unroll
            for (int bb = 0; bb < 2; ++bb) acc[a][bb] = f32x16{};
        const int Dlo = (8 * wave - 63) > -63 ? (8 * wave - 63) : -63, Dhi = (8 * wave + 7) < 63 ? (8 * wave + 7) : 63;
        const LAS unsigned char* zb = Zs + (r32 & 7) * ZPITCH + hi * 16;
        const LAS unsigned char* apar = (const LAS unsigned char*)rl + (r32 & 1) * RG1_LDS;
#define HY_BODY(DO0, DO1) do { \
            bf16x8 A6[6]; \
            const LAS unsigned* ap = (const LAS unsigned*)(apar + (4096 - 64 * D - 32 + 8 * hi - r32 - (r32 & 1)) * 2);     \
            _Pragma("unroll") for (int q = 0; q < 6; ++q) { v4u w; w.x = ap[8 * q]; w.y = ap[8 * q + 1]; w.z = ap[8 * q + 2]; w.w = ap[8 * q + 3]; A6[q] = __builtin_bit_cast(bf16x8, w); } \
            bf16x8 Bf[2][4]; \
            _Pragma("unroll") for (int ct = 0; ct < 2; ++ct) { if (ct == 0 ? (DO0) : (DO1)) { const int J = 8 * wave + 4 * ct + (r32 >> 3) - D; const bool ok = (unsigned)J < 64u; \
                _Pragma("unroll") for (int ks = 0; ks < 4; ++ks) { bf16x8 z = bf16x8{}; if (ok) z = *(const LAS bf16x8*)(zb + (64 * J + 16 * ks) * 2); Bf[ct][ks] = z; } } } \
            __builtin_amdgcn_s_setprio(1); \
            _Pragma("unroll") for (int ks = 0; ks < 4; ++ks) _Pragma("unroll") for (int rt = 0; rt < 2; ++rt) _Pragma("unroll") for (int ct = 0; ct < 2; ++ct) \
                if (ct == 0 ? (DO0) : (DO1)) acc[rt][ct] = __builtin_amdgcn_mfma_f32_32x32x16_bf16(A6[ks - 2 * rt + 2], Bf[ct][ks], acc[rt][ct], 0, 0, 0); \
            __builtin_amdgcn_s_setprio(0); } while (0)
        { int D = Dlo;
          for (; D < 8 * wave - 59; ++D) HY_BODY(true, false);
          for (; D <= 8 * wave + 3; ++D) HY_BODY(true, true);
          for (; D <= Dhi; ++D) HY_BODY(false, true); }
#undef HY_BODY
        const int b = r32 & 7;
#pragma unroll
        for (int rt = 0; rt < 2; ++rt)
#pragma unroll
            for (int ct = 0; ct < 2; ++ct) { const int I = 8 * wave + 4 * ct + (r32 >> 3);
#pragma unroll
                for (int k2 = 0; k2 < 2; ++k2) { v2u pk[2];
#pragma unroll
                    for (int rr = 0; rr < 2; ++rr) { const int r4 = 2 * k2 + rr, t = 64 * I + 32 * rt + 8 * r4 + 4 * hi;
                        const v2u zz = *(const LAS v2u*)(Zs + b * ZPITCH + t * 2);
                        const float y0 = acc[rt][ct][4 * r4 + 0] * invn + bias * bflo(zz.x), y1 = acc[rt][ct][4 * r4 + 1] * invn + bias * bfhi(zz.x);
                        const float y2 = acc[rt][ct][4 * r4 + 2] * invn + bias * bflo(zz.y), y3 = acc[rt][ct][4 * r4 + 3] * invn + bias * bfhi(zz.y);
                        pk[rr].x = pk2(y0, y1); pk[rr].y = pk2(y2, y3); }
                    const auto sx = __builtin_amdgcn_permlane32_swap(pk[0].x, pk[1].x, false, false); const auto sy = __builtin_amdgcn_permlane32_swap(pk[0].y, pk[1].y, false, false);
                    v4u o; o.x = sx[0]; o.y = sy[0]; o.z = sx[1]; o.w = sy[1];
                    *(v4u*)(YT + ((size_t)c * BATCH + b) * SEQ + 64 * I + 32 * rt + 16 * k2 + 8 * hi) = o; } }
        __syncthreads();
    }
}

__device__ __forceinline__ void phase_combine(int l, LAS unsigned char* lds, int G) {
    const int tid = fresh_tid(), lane = tid & 63, wave = __builtin_amdgcn_readfirstlane(tid >> 6);
    const KParams P = fresh_params(); unsigned char* ws = P->ws;
    const bf16r* PROJ = (const bf16r*)(ws + WS_PROJ); const bf16r* OC = (const bf16r*)(ws + WS_OC);
    const bf16r* YT = (const bf16r*)(ws + WS_YT); bf16r* Y = (bf16r*)(ws + WS_H);
    const float* cw = P->in[9] + l * 3 * 768; const float* cbv = P->in[10] + l * 768; const float* scw = P->in[25] + l * 3 * 256; const float* subln = P->in[24] + l * 64;
    float lam;
    { float s1 = 0.f, s2 = 0.f;
      for (int i = 0; i < 32; ++i) { s1 += P->in[20][l * 32 + i] * P->in[21][l * 32 + i]; s2 += P->in[22][l * 32 + i] * P->in[23][l * 32 + i]; }
      lam = expf(s1) - expf(s2) + P->lam_init[l]; }
    const float oml = 1.0f - P->lam_init[l];
    LAS bf16r* yt = (LAS bf16r*)lds;
    const int c8 = tid & 31, rgp = tid >> 5, c = 8 * c8;
    for (int tile = blockIdx.x; tile < MROWS / 64; tile += G) {
        const int b = tile >> 6, t0 = (tile & 63) * 64; const size_t row0 = (size_t)tile * 64;
        const int tl0 = 4 * rgp, tb = t0 + tl0;
        const bf16r* base = PROJ + (row0 + tl0) * DIN + c;
        v4u xw[6]; float uw[6][8];
#pragma unroll
        for (int q = 0; q < 6; ++q) { const int t = tb + q - 1; const bool ok = (t >= 0) && (t < SEQ);
            v4u a = (v4u){0u, 0u, 0u, 0u}, g = a;
            if (ok) { const bf16r* pr = base + (long)(q - 1) * DIN; a = *(const v4u*)(pr + C_BP); g = *(const v4u*)(pr + C_DP + 256); }
            xw[q] = a; unpack8(g, uw[q]); }
#pragma unroll 8
        for (int i = 0; i < 16; ++i) { const int cc = 32 * wave + 2 * i + (lane >> 5), tl = 2 * (lane & 31);
            *(LAS unsigned*)(yt + cc * YTP + tl) = *(const unsigned*)(YT + ((size_t)cc * BATCH + b) * SEQ + t0 + tl); }
        __syncthreads();
#pragma unroll
        for (int r = 0; r < 4; ++r) {
            const bf16r* pr = base + (size_t)r * DIN; const size_t row = row0 + tl0 + r;
            bf16r* yrow = Y + row * DMODEL + c;
            float g[8], o[8], y[8];
            { unpack8(*(const v4u*)(pr + C_BG), g); float xa[8], xb[8], xc[8]; unpack8(xw[r], xa); unpack8(xw[r + 1], xb); unpack8(xw[r + 2], xc);
#pragma unroll
              for (int e = 0; e < 8; ++e) { const float x0 = cw[c + e] * xa[e] + cw[768 + c + e] * xb[e] + cw[1536 + c + e] * xc[e] + cbv[c + e];
                  y[e] = silu_f(g[e]) * x0 * bf1(yt[(c + e) * YTP + tl0 + r]); }
              *(v4u*)(yrow + 256) = pack8(y); }
            { unpack8(*(const v4u*)(pr + C_DP), o);
#pragma unroll
              for (int e = 0; e < 8; ++e) y[e] = o[e] * (scw[c + e] * uw[r][e] + scw[256 + c + e] * uw[r + 1][e] + scw[512 + c + e] * uw[r + 2][e]);
              *(v4u*)(yrow + 768) = pack8(y); }
        }
        __syncthreads();
    }
}

struct EpiProj {
    static constexpr bool PERM = false, AFTER_DRAIN = false;
    int l;
    __device__ __forceinline__ static v2u pk4(float a, float b, float c, float d) { v2u o; o.x = pg8::cvt_pk_bf16(a, b); o.y = pg8::cvt_pk_bf16(c, d); return o; }
    __device__ __forceinline__ static void store_pair16(bf16r* blk, int fq, v2u o1, v2u o2) {
        const auto sx = __builtin_amdgcn_permlane16_swap(o1.x, o2.x, false, false); const auto sy = __builtin_amdgcn_permlane16_swap(o1.y, o2.y, false, false);
        v4u w; w.x = sx[0]; w.y = sy[0]; w.z = sx[1]; w.w = sy[1];
        *(v4u*)(blk + ((fq & 1) ? 16 + 4 * (fq - 1) : 4 * fq)) = w;
    }
    __device__ __forceinline__ void head64(const pg8::f32x4 (&acc)[2][2][4][2], int row0, int fq, bf16r* dst, int pitch, int colbase, const float* gain, float scale, const float2* trc) const {
        pg8::f32x4 g[2][2], rcs[2][2];
#pragma unroll
        for (int bj = 0; bj < 2; ++bj) { g[bj][0] = *(const pg8::f32x4*)(gain + 32 * bj + 4 * fq); g[bj][1] = *(const pg8::f32x4*)(gain + 32 * bj + 16 + 4 * fq); }
#pragma unroll
        for (int ai = 0; ai < 2; ++ai) { const float2* tab = trc + (((row0 + ai * 128) & (SEQ - 1)) >> 6) * 16 + 4 * fq; rcs[ai][0] = *(const pg8::f32x4*)tab; rcs[ai][1] = *(const pg8::f32x4*)(tab + 2); }
#pragma unroll
        for (int mh = 0; mh < 2; ++mh) {
            pg8::f32x4 ccs[2][2];
#pragma unroll
            for (int mm = 0; mm < 2; ++mm) { const float2* tab = trc + ((row0 + (2 * mh + mm) * 16) & 63) * 16 + 4 * fq; ccs[mm][0] = *(const pg8::f32x4*)tab; ccs[mm][1] = *(const pg8::f32x4*)(tab + 2); }
            asm volatile("" ::: "memory");
#pragma unroll
        for (int mm = 0; mm < 2; ++mm)
#pragma unroll
            for (int ai = 0; ai < 2; ++ai) { const int m = 2 * mh + mm; const int row = row0 + ai * 128 + m * 16;
                float ss = 0.f;
#pragma unroll
                for (int bj = 0; bj < 2; ++bj)
#pragma unroll
                    for (int n = 0; n < 2; ++n) { const pg8::f32x4 v = acc[ai][bj][m][n]; ss += (v[0] * v[0] + v[1] * v[1]) + (v[2] * v[2] + v[3] * v[3]); }
                ss += __shfl_xor(ss, 16); ss += __shfl_xor(ss, 32);
                const float rstd = rsqrtf(ss * (1.f / 64.f) + EPS);
#pragma unroll
                for (int bj = 0; bj < 2; ++bj) { const pg8::f32x4 cs01 = bj == 0 ? rcs[ai][0] : ccs[mm][0], cs23 = bj == 0 ? rcs[ai][1] : ccs[mm][1];
                    const pg8::f32x4 x1 = acc[ai][bj][m][0] * g[bj][0] * (rstd * scale), x2 = acc[ai][bj][m][1] * g[bj][1] * (rstd * scale);
                    const float c0 = cs01[0], s0 = cs01[1], c1 = cs01[2], s1 = cs01[3], c2 = cs23[0], s2 = cs23[1], c3 = cs23[2], s3 = cs23[3];
                    store_pair16(dst + (size_t)row * pitch + colbase + 32 * bj, fq, pk4(x1[0] * c0 - x2[0] * s0, x1[1] * c1 - x2[1] * s1, x1[2] * c2 - x2[2] * s2, x1[3] * c3 - x2[3] * s3),
                                 pk4(x2[0] * c0 + x1[0] * s0, x2[1] * c1 + x1[1] * s1, x2[2] * c2 + x1[2] * s2, x2[3] * c3 + x1[3] * s3)); } } }
    }
    __device__ __forceinline__ void sub32(const pg8::f32x4 (&acc)[2][2][4][2], int row0, int wc, int fq, bf16r* dst, const float* gain, float scale, const float2* tseq) const {
        const pg8::f32x4 g1 = *(const pg8::f32x4*)(gain + 4 * fq), g2 = *(const pg8::f32x4*)(gain + 16 + 4 * fq);
#pragma unroll
        for (int ai = 0; ai < 2; ++ai) {
            pg8::f32x4 cs[4][2];
#pragma unroll
            for (int m = 0; m < 4; ++m) { const float2* tab = tseq + ((row0 + ai * 128 + m * 16) & (SEQ - 1)) * 16 + 4 * fq; cs[m][0] = *(const pg8::f32x4*)tab; cs[m][1] = *(const pg8::f32x4*)(tab + 2); }
            asm volatile("" ::: "memory");
#pragma unroll
            for (int m = 0; m < 4; ++m) { const int row = row0 + ai * 128 + m * 16;
                const pg8::f32x4 cs01 = cs[m][0], cs23 = cs[m][1];
                const float c0 = cs01[0], s0 = cs01[1], c1 = cs01[2], s1 = cs01[3], c2 = cs23[0], s2 = cs23[1], c3 = cs23[2], s3 = cs23[3];
#pragma unroll
                for (int bj = 0; bj < 2; ++bj) { const pg8::f32x4 a = acc[ai][bj][m][0], b = acc[ai][bj][m][1];
                    float ss = ((a[0] * a[0] + a[1] * a[1]) + (a[2] * a[2] + a[3] * a[3])) + ((b[0] * b[0] + b[1] * b[1]) + (b[2] * b[2] + b[3] * b[3]));
                    ss += __shfl_xor(ss, 16); ss += __shfl_xor(ss, 32);
                    const float rs = rsqrtf(ss * (1.f / 32.f) + EPS) * scale;
                    const pg8::f32x4 x1 = a * g1 * rs, x2 = b * g2 * rs;
                    store_pair16(dst + (size_t)row * 256 + (4 * bj + wc) * 32, fq, pk4(x1[0] * c0 - x2[0] * s0, x1[1] * c1 - x2[1] * s1, x1[2] * c2 - x2[2] * s2, x1[3] * c3 - x2[3] * s3),
                                 pk4(x2[0] * c0 + x1[0] * s0, x2[1] * c1 + x1[1] * s1, x2[2] * c2 + x1[2] * s2, x2[3] * c3 + x1[3] * s3));
                    } } }
    }
    __device__ __forceinline__ void plain(const pg8::f32x4 (&acc)[2][2][4][2], int row0, bf16r* dst0, int off_bj1) const {
#pragma unroll
        for (int ai = 0; ai < 2; ++ai)
#pragma unroll
            for (int m = 0; m < 4; ++m) { bf16r* d = dst0 + (size_t)(row0 + ai * 128 + m * 16) * DIN;
#pragma unroll
                for (int bj = 0; bj < 2; ++bj) { const pg8::f32x4 v0 = acc[ai][bj][m][0], v1 = acc[ai][bj][m][1];
                    v4u w; w.x = pg8::cvt_pk_bf16(v0[0], v0[1]); w.y = pg8::cvt_pk_bf16(v0[2], v0[3]); w.z = pg8::cvt_pk_bf16(v1[0], v1[1]); w.w = pg8::cvt_pk_bf16(v1[2], v1[3]);
                    *(v4u*)(d + bj * off_bj1) = w; } }
    }
    template <bool SILU> __device__ __forceinline__ void pairmul(const pg8::f32x4 (&acc)[2][2][4][2], int row0, bf16r* dst0) const {
#pragma unroll
        for (int ai = 0; ai < 2; ++ai)
#pragma unroll
            for (int m = 0; m < 4; ++m) { float y[8];
#pragma unroll
                for (int n = 0; n < 2; ++n)
#pragma unroll
                    for (int e = 0; e < 4; ++e) { const float p = acc[ai][0][m][n][e], q = acc[ai][1][m][n][e]; y[4 * n + e] = SILU ? silu_f(q) * p : p * q; }
                *(v4u*)(dst0 + (size_t)(row0 + ai * 128 + m * 16) * DIN) = pack8(y); }
    }
    __device__ __forceinline__ static v2u quadT(const pg8::f32x4 v, bool o1, bool o2) {
        const float p0 = __shfl_xor(o1 ? v[0] : v[1], 1), p1 = __shfl_xor(o1 ? v[2] : v[3], 1);
        const float a0 = o1 ? p0 : v[0], a1 = o1 ? v[1] : p0, a2 = o1 ? p1 : v[2], a3 = o1 ? v[3] : p1;
        const float r0 = __shfl_xor(o2 ? a0 : a2, 2), r1 = __shfl_xor(o2 ? a1 : a3, 2);
        return pk4(o2 ? r0 : a0, o2 ? r1 : a1, o2 ? a2 : r0, o2 ? a3 : r1);
    }
    __device__ __forceinline__ void transposed(const pg8::f32x4 (&acc)[2][2][4][2], int row0, int fr, bf16r* dstT, int cbase) const {
        const int q = fr & 3; const bool o1 = q & 1, o2 = q & 2, up = fr & 4;
#pragma unroll
        for (int ai = 0; ai < 2; ++ai)
#pragma unroll
            for (int m = 0; m < 4; ++m) { const int row = row0 + ai * 128 + m * 16, b = row >> 12, t8 = (row & (SEQ - 1)) & ~7;
#pragma unroll
                for (int bj = 0; bj < 2; ++bj) { const v2u k0 = quadT(acc[ai][bj][m][0], o1, o2), k1 = quadT(acc[ai][bj][m][1], o1, o2);
                    const unsigned rx = __shfl_xor(up ? k0.x : k1.x, 4), ry = __shfl_xor(up ? k0.y : k1.y, 4);
                    v4u w; if (up) { w.x = rx; w.y = ry; w.z = k1.x; w.w = k1.y; } else { w.x = k0.x; w.y = k0.y; w.z = rx; w.w = ry; }
                    const int cc = 128 * bj + cbase + (up ? 16 : 0) + q;
                    *(v4u*)(dstT + ((size_t)cc * BATCH + b) * SEQ + t8) = w; } }
    }
    __device__ __forceinline__ void operator()(const pg8::f32x4 (&acc)[2][2][4][2], const pg8::Unit& u, int wr, int wc, int fr, int fq) const {
        constexpr float L2E = 1.4426950408889634f;
        const int row0 = u.pm * 256 + wr * 64 + fr, pn = win_p2l(u.pn);
        const KParams P = fresh_params(); unsigned char* ws = P->ws;
        bf16r* PROJ = (bf16r*)(ws + WS_PROJ); bf16r* QA = (bf16r*)(ws + WS_QA); bf16r* KA = (bf16r*)(ws + WS_KA); bf16r* QC = (bf16r*)(ws + WS_QC); bf16r* KC = (bf16r*)(ws + WS_KC);
        bf16r* X1T = (bf16r*)(ws + WS_ZT); bf16r* VT = (bf16r*)(ws + WS_OA);
        const float* aqn = P->in[7] + l * 64; const float* akn = P->in[8] + l * 64; const float* cqn = P->in[18] + l * 32; const float* ckn = P->in[19] + l * 32;
        const float2* tseq = (const float2*)(ws + WS_TABSEQ); const float2* trc = (const float2*)(ws + WS_TABRC);
        if (pn == 0) head64(acc, row0, fq, QA, 256, 64 * wc, aqn, 0.125f * L2E, trc);
        else if (pn == 1) { if (wc < 2) head64(acc, row0, fq, KA, 128, 64 * wc, akn, 1.0f, trc);
                            else plain(acc, row0, PROJ + C_AV + 32 * (wc - 2) + 8 * fq, 64); }
        else if (pn == 7) sub32(acc, row0, wc, fq, QC, cqn, 0.17677669529663687f * L2E, tseq);
        else if (pn == 8) sub32(acc, row0, wc, fq, KC, ckn, 1.0f, tseq);
        else if (pn == 11 || pn == 12) pairmul<true>(acc, row0, PROJ + C_DP + 128 * (pn - 11) + 32 * wc + 8 * fq);
        else if (pn == 13 || pn == 14) pairmul<false>(acc, row0, PROJ + C_DP + 256 + 128 * (pn - 13) + 32 * wc + 8 * fq);
        else if (pn == 4) transposed(acc, row0, fr, X1T, 32 * wc + 4 * fq);
        else if (pn == 5) transposed(acc, row0, fr, VT, 32 * wc + 4 * fq);
        else plain(acc, row0, PROJ + pn * 256 + 32 * wc + 8 * fq, 128);
    }
};

struct EpiGateBf16 {
    static constexpr bool PERM = true, AFTER_DRAIN = false;
    pg8::bf16_t* O; const float* gate; int pitch; bool park;
    __device__ __forceinline__ void operator()(const pg8::f32x4 (&acc)[2][2][4][2], const pg8::Unit& u, int wr, int wc, int fr, int fq) const {
        const int row0 = u.pm * 256 + wr * 64 + fr, col0 = u.pn * 256 + wc * 32 + 8 * fq;
        const float* gb = gate + (u.pm >> 4) * 3072 + col0;
        pg8::f32x4 gv[2][2];
#pragma unroll
        for (int bj = 0; bj < 2; ++bj)
#pragma unroll
            for (int n = 0; n < 2; ++n) gv[bj][n] = *(const pg8::f32x4*)(gb + bj * 128 + 4 * n);
        int cmap[2];
#pragma unroll
        for (int bj = 0; bj < 2; ++bj) cmap[bj] = park ? d0_col(col0 + bj * 128) : col0 + bj * 128;
#pragma unroll
        for (int ai = 0; ai < 2; ++ai)
#pragma unroll
            for (int m = 0; m < 4; ++m) { pg8::bf16_t* rowp = O + (size_t)(row0 + ai * 128 + m * 16) * pitch;
#pragma unroll
                for (int bj = 0; bj < 2; ++bj) { const pg8::f32x4 v0 = acc[ai][bj][m][0] * gv[bj][0], v1 = acc[ai][bj][m][1] * gv[bj][1];
                    pg8::u32x4 w; w.x = pg8::cvt_pk_bf16(v0[0], v0[1]); w.y = pg8::cvt_pk_bf16(v0[2], v0[3]); w.z = pg8::cvt_pk_bf16(v1[0], v1[1]); w.w = pg8::cvt_pk_bf16(v1[2], v1[3]);
                    *(pg8::u32x4*)(rowp + cmap[bj]) = w; } }
    }
};

__device__ __forceinline__ void phase_gemm1(int l, LAS unsigned char* lds, int G, int bx) {
    const KParams P = fresh_params(); unsigned char* ws = P->ws;
    pg8::Gemm g{(const pg8::bf16_t*)(ws + WS_H), (const pg8::bf16_t*)(ws + WS_WIN) + (size_t)l * DIN * DMODEL, MROWS, DIN, DMODEL};
    pg8::StaticOrder S; S.init(MROWS, DIN, G, bx);
    EpiProj E{l};
    pg8::gemm_phase<EpiProj, pg8::StaticOrder, PG8_ALIGN, PG8_SP2>(lds, g, S, E);
}
__device__ __forceinline__ void phase_gemm2(int l, LAS unsigned char* lds, int G, int bx) {
    const KParams P = fresh_params(); unsigned char* ws = P->ws;
    pg8::Gemm g{(const pg8::bf16_t*)(ws + WS_H), (const pg8::bf16_t*)(ws + WS_WOUT) + (size_t)l * DMODEL * DMODEL, MROWS, DMODEL, DMODEL};
    pg8::StaticOrder S; S.init(MROWS, DMODEL, G, bx);
    EpiGateBf16 E{(pg8::bf16_t*)(ws + (l == 0 ? WS_PROJ : WS_DELTA)), (const float*)(ws + WS_MOD) + (size_t)l * 8 * 3072 + 2048, l == 0 ? DIN : DMODEL, l == 0};
    pg8::gemm_phase<EpiGateBf16, pg8::StaticOrder, PG8_ALIGN, PG8_SP2>(lds, g, S, E);
}
__device__ __forceinline__ void phase_final(int vcu, int G) {
    const KParams P = fresh_params(); unsigned char* ws = P->ws;
    const int tid = fresh_tid();
    float* out = P->out; const float* xin = P->in[0]; const bf16r* DL = (const bf16r*)(ws + WS_DELTA); const bf16r* D0 = (const bf16r*)(ws + WS_PROJ);
    const unsigned n8 = (unsigned)MROWS * DMODEL / 8;
    for (unsigned i = (unsigned)vcu * NTHR + tid; i < n8; i += (unsigned)G * NTHR) {
        const unsigned row = i >> 7, col = (i & 127) * 8;
        const v4u d = *(const v4u*)(DL + (size_t)i * 8), e = *(const v4u*)(D0 + (size_t)row * DIN + d0_col((int)col));
        f32x4 a = *(const f32x4*)(xin + (size_t)i * 8), b = *(const f32x4*)(xin + (size_t)i * 8 + 4);
        a.x += bflo(d.x) + bflo(e.x); a.y += bfhi(d.x) + bfhi(e.x); a.z += bflo(d.y) + bflo(e.y); a.w += bfhi(d.y) + bfhi(e.y);
        b.x += bflo(d.z) + bflo(e.z); b.y += bfhi(d.z) + bfhi(e.z); b.z += bflo(d.w) + bflo(e.w); b.w += bfhi(d.w) + bfhi(e.w);
        *(f32x4*)(out + (size_t)i * 8) = a; *(f32x4*)(out + (size_t)i * 8 + 4) = b; }
}
__device__ __forceinline__ void phase_attn(int l, char* lds_generic, int vcu, int G) {
    const KParams P = fresh_params(); unsigned char* ws = P->ws;
    using abf = attn_body::bf16;
    float bA, bC;
    { float gq = 0.f, gk = 0.f, cq = 0.f, ck = 0.f;
      for (int i = 0; i < 64; ++i) { gq = fmaxf(gq, fabsf(P->in[7][l * 64 + i])); gk = fmaxf(gk, fabsf(P->in[8][l * 64 + i])); }
      for (int i = 0; i < 32; ++i) { cq = fmaxf(cq, fabsf(P->in[18][l * 32 + i])); ck = fmaxf(ck, fabsf(P->in[19][l * 32 + i])); }
      bA = 64.f * 0.125f * 1.4426950408889634f * 1.03f * gq * gk; bC = 32.f * 0.17677669529663687f * 1.4426950408889634f * 1.03f * cq * ck; }
    const bool fix = (bA < 40.f) && (bC < 40.f);
    float lam;
    { float s1 = 0.f, s2 = 0.f;
      for (int i = 0; i < 32; ++i) { s1 += P->in[20][l * 32 + i] * P->in[21][l * 32 + i]; s2 += P->in[22][l * 32 + i] * P->in[23][l * 32 + i]; }
      lam = expf(s1) - expf(s2) + P->lam_init[l]; }
    const float oml = 1.0f - P->lam_init[l]; const float* subln = P->in[24] + l * 64;
#define ATTN_A_ARGS \
        const int grp = u >> 4, qb = u & 15, b = grp >> 2, h = grp & 3; \
        const abf* Q = (const abf*)(ws + WS_QA) + h * 64; const abf* K = (const abf*)(ws + WS_KA) + (h >> 1) * 64; const abf* V = (const abf*)(ws + WS_PROJ) + C_AV + (h >> 1) * 64; \
        abf* O = (abf*)(ws + WS_H) + h * 64; const abf* Gt = (const abf*)(ws + WS_PROJ) + C_AG + h * 64;
#define ATTN_C_ARGS \
        const int cgp = du >> 4, qb = du & 15, b = cgp >> 2, hd = cgp & 3, h = 2 * hd + mp; \
        const abf* Q = (const abf*)(ws + WS_QC) + h * 32; const abf* K = (const abf*)(ws + WS_KC) + h * 32; const abf* V = (const abf*)(ws + WS_PROJ) + C_CV + hd * 64; \
        abf* O = (abf*)(ws + WS_H) + 512 + hd * 64; \
        const abf* Gt = mp ? (const abf*)(ws + WS_PROJ) + C_CG + hd * 64 : (const abf*)nullptr;
    attn_body::u32x4 okeep[4] = {};
    if (fix) {
        for (int u = vcu; u < 32 * 16; u += G) { ATTN_A_ARGS
            attn_body::attn_unit<8, true, false>(bA, (long)b * SEQ, qb * 256, Q, 256, K, 128, V, DIN, O, DMODEL, Gt, DIN, okeep, 0, 0.f, 0.f, subln, lds_generic); }
        for (int du = vcu; du < 32 * 16; du += G)
            for (int mp = 0; mp < 2; ++mp) { ATTN_C_ARGS
                attn_body::attn_unit<8, true, true>(bC, (long)b * SEQ, qb * 256, Q, 256, K, 256, V, DIN, O, DMODEL, Gt, DIN, okeep, 1 + mp, lam, oml, subln, lds_generic); }
    } else {
        for (int u = vcu; u < 32 * 16; u += G) { ATTN_A_ARGS
            attn_body::attn_unit<8, false, false>(0.f, (long)b * SEQ, qb * 256, Q, 256, K, 128, V, DIN, O, DMODEL, Gt, DIN, okeep, 0, 0.f, 0.f, subln, lds_generic); }
        for (int du = vcu; du < 32 * 16; du += G)
            for (int mp = 0; mp < 2; ++mp) { ATTN_C_ARGS
                attn_body::attn_unit<8, false, true>(0.f, (long)b * SEQ, qb * 256, Q, 256, K, 256, V, DIN, O, DMODEL, Gt, DIN, okeep, 1 + mp, lam, oml, subln, lds_generic); }
    }
#undef ATTN_A_ARGS
#undef ATTN_C_ARGS
}
#define XB_TMO      128
#define XB_XCNT(j)  (256  + 64 * (j))
#define XB_XSUB(j)  (1280 + 64 * (j))
#define XB_XGEN(j)  (2304 + 64 * (j))
#define XB_TOP      3328
#define XB_TOPGEN   3392
#define XCD_BAR_WORDS 3456
#define XB_SPIN_CAP (1u << 18)

__device__ __forceinline__ unsigned xb_ld(unsigned* p)              { return __hip_atomic_load(p, __ATOMIC_RELAXED, __HIP_MEMORY_SCOPE_AGENT); }
__device__ __forceinline__ unsigned xb_add(unsigned* p, unsigned v) { return __hip_atomic_fetch_add(p, v, __ATOMIC_RELAXED, __HIP_MEMORY_SCOPE_AGENT); }
__device__ __forceinline__ unsigned xb_xcc_id() { return (unsigned)__builtin_amdgcn_s_getreg((3 << 11) | 20) & 0xFu; }
#define XB_SPIN(cond, bar) do { unsigned _sp = 0; while (cond) { __builtin_amdgcn_s_sleep(1); \
    if ((++_sp & 255u) == 0u) { if (xb_ld(&(bar)[XB_TMO])) break; if (_sp > XB_SPIN_CAP) { atomicAdd(&(bar)[XB_TMO], 1u); break; } } } } while (0)

struct XcdBarrier {
    unsigned* bar; unsigned x;
    volatile LAS unsigned* st;
};

__device__ __forceinline__ XcdBarrier xcd_barrier_post(unsigned* bar, volatile LAS unsigned* st) {
    XcdBarrier b; b.bar = bar; b.x = xb_xcc_id(); b.st = st;
    if (threadIdx.x == 0) (void)xb_add(&bar[XB_XCNT(b.x)], 1u);
    return b;
}
__device__ __forceinline__ void xcd_barrier_complete(unsigned* bar, unsigned x, unsigned& nloc, unsigned& nx) {
    const unsigned G = gridDim.x * gridDim.y * gridDim.z;
    unsigned sum, cnt, mine, sp = 0u;
    for (;;) {
        sum = 0u; cnt = 0u; mine = 0u;
#pragma unroll
        for (unsigned j = 0; j < 16; ++j) { const unsigned c = xb_ld(&bar[XB_XCNT(j)]); sum += c; cnt += (c > 0u) ? 1u : 0u; mine = (j == x) ? c : mine; }
        if (sum == G) break;
        __builtin_amdgcn_s_sleep(1);
        if ((++sp & 255u) == 0u) { if (xb_ld(&bar[XB_TMO])) break; if (sp > XB_SPIN_CAP) { atomicAdd(&bar[XB_TMO], 1u); break; } }
    }
    nloc = mine > 0u ? mine : 1u; nx = cnt > 0u ? cnt : 1u;
}

__device__ __forceinline__ void xcd_barrier(const XcdBarrier& b) {
    asm volatile("s_waitcnt vmcnt(0)" ::: "memory");
    __syncthreads();
    if (threadIdx.x == 0) {
        unsigned* bar = b.bar;
        __builtin_amdgcn_s_waitcnt(0);
        unsigned nloc = b.st[0], nx = b.st[1];
        if (nloc == 0u) { xcd_barrier_complete(bar, b.x, nloc, nx); b.st[0] = nloc; b.st[1] = nx; }
        const unsigned old = xb_add(&bar[XB_XSUB(b.x)], 1u);
        const unsigned gen = old / nloc;
        if (old + 1u == (gen + 1u) * nloc) {
            __builtin_amdgcn_fence(__ATOMIC_RELEASE, "agent");
            asm volatile("s_waitcnt vmcnt(0)" ::: "memory");
            const unsigned og = xb_add(&bar[XB_TOP], 1u);
            const unsigned tg = og / nx;
            if (og + 1u == (tg + 1u) * nx) xb_add(&bar[XB_TOPGEN], 1u);
            else XB_SPIN(xb_ld(&bar[XB_TOPGEN]) == tg, bar);
            __builtin_amdgcn_fence(__ATOMIC_ACQUIRE, "agent");
            xb_add(&bar[XB_XGEN(b.x)], 1u);
            asm volatile("s_waitcnt vmcnt(0)" ::: "memory");
        } else {
            XB_SPIN(xb_ld(&bar[XB_XGEN(b.x)]) == gen, bar);
            __builtin_amdgcn_fence(__ATOMIC_ACQUIRE, "agent");
            asm volatile("s_waitcnt vmcnt(0)" ::: "memory");
        }
    }
    __syncthreads();
}

#ifndef PM
#define PM 255
#endif
#ifndef REP_G2L0
#define REP_G2L0 1
#endif
#ifndef REP_PRO
#define REP_PRO 1
#endif
#ifndef REP_NORM
#define REP_NORM 1
#endif
#ifndef REP_G1
#define REP_G1 1
#endif
#ifndef REP_PREP
#define REP_PREP 1
#endif
#ifndef REP_ATTN
#define REP_ATTN 1
#endif
#ifndef REP_HY
#define REP_HY 1
#endif
#ifndef REP_COMB
#define REP_COMB 1
#endif
#ifndef REP_SYNC
#define REP_SYNC 1
#endif
__global__ void __launch_bounds__(NTHR, 2) hymba_fwd(Params Pk) {
    extern __shared__ __attribute__((aligned(16))) unsigned char lds_raw[];
    LAS unsigned char* lds = (LAS unsigned char*)lds_raw;
    cg::grid_group grid = cg::this_grid();
    const int G = gridDim.x, bx = blockIdx.x, vcu = (G % 8 == 0) ? (bx % 8) * (G / 8) + bx / 8 : bx;
    if (threadIdx.x < 8) ((LAS unsigned*)(lds + MISC_OFF))[threadIdx.x] = 0u;
    __syncthreads();
    XcdBarrier bar = xcd_barrier_post((unsigned*)(fresh_params()->ws + WS_BAR), (volatile LAS unsigned*)(lds + MISC_OFF));
#define GSYNC() xcd_barrier(bar)
#if PM & 1
    for (int rp = 0; rp < REP_PRO; ++rp) phase_prologue(lds, vcu, G, rp == 0);
#endif
    if (G == 0x7fffffff) grid.sync();
    GSYNC();
    for (int l = 0; l < DEPTH; ++l) {
#if PM & 2
        for (int rp = 0; rp < REP_NORM; ++rp) phase_norm(l, vcu, G);
#endif
        GSYNC();
#if PM & 4
        for (int rp = 0; rp < REP_G1; ++rp) phase_gemm1(l, lds, G, bx);
#endif
        GSYNC();
#if PM & 16
        for (int rp = 0; rp < REP_ATTN; ++rp) phase_attn(l, (char*)lds_raw, vcu, G);
        __syncthreads();
#endif
#if PM & 32
        for (int rp = 0; rp < REP_HY; ++rp) phase_hyena(l, lds, G);
#endif
        GSYNC();
#if PM & 64
        for (int rp = 0; rp < REP_COMB; ++rp) phase_combine(l, lds, G);
#endif
        GSYNC();
#if PM & 128
        for (int rp = 0; rp < REP_G2L0; ++rp) phase_gemm2(l, lds, G, bx);
#endif
        for (int rp = 0; rp < REP_SYNC; ++rp) GSYNC();
    }
    phase_final(vcu, G);
}

extern "C" void kernel_launch(void* const* d_in, const int* in_sizes, int n_in, void* d_out, int out_size, void* d_ws, size_t ws_size, hipStream_t stream) {
    static int grid = 0;
    if (grid == 0) {
        if (n_in != 26 || out_size != MROWS * DMODEL || ws_size < WS_END) { fprintf(stderr, "kernel_launch: unexpected shapes (n_in %d out %d ws %zu)\n", n_in, out_size, ws_size); grid = -1; return; }
        int dev = 0, cus = 0, per_cu = 0;
        hipGetDevice(&dev); hipDeviceGetAttribute(&cus, hipDeviceAttributeMultiprocessorCount, dev);
        if (hipFuncSetAttribute((const void*)hymba_fwd, hipFuncAttributeMaxDynamicSharedMemorySize, LDS_BYTES) != hipSuccess) { fprintf(stderr, "hipFuncSetAttribute failed\n"); grid = -1; return; }
        if (hipOccupancyMaxActiveBlocksPerMultiprocessor(&per_cu, (const void*)hymba_fwd, NTHR, LDS_BYTES) != hipSuccess || per_cu < 1) { fprintf(stderr, "occupancy query: %d\n", per_cu); per_cu = 1; }
        (void)hipGetLastError();
        grid = cus * 1;
    }
    if (grid < 0) return;
    hipMemsetAsync((char*)d_ws + WS_CTL, 0, CTL_ZERO_BYTES, stream);
    Params p{};
    for (int i = 0; i < 26; ++i) p.in[i] = (const float*)d_in[i];
    p.out = (float*)d_out; p.ws = (unsigned char*)d_ws;
    for (int i = 0; i < 16; ++i) p.inv[i] = (float)pow(10000.0, -(double)i / 16.0);
    for (int l = 0; l < 2; ++l) p.lam_init[l] = (float)(0.8 - 0.6 * exp(-0.3 * (double)l));
    void* args[] = {&p};
    hipError_t e = hipLaunchCooperativeKernel((const void*)hymba_fwd, dim3(grid), dim3(NTHR), args, LDS_BYTES, stream);
    if (e != hipSuccess) fprintf(stderr, "cooperative launch failed: %s (grid %d)\n", hipGetErrorString(e), grid);
}
```

```cpp
#include <hip/hip_cooperative_groups.h>
#include <hip/hip_runtime.h>
#include <cstdio>
#include <cstdint>
__device__ __forceinline__ int fresh_tid() { int t = threadIdx.x; asm volatile("" : "+v"(t)); return t; }
namespace pg8 {
#define PG8_LAS __attribute__((address_space(3)))
typedef unsigned short bf16_t;
typedef short bf16x8 __attribute__((ext_vector_type(8)));
typedef float f32x4 __attribute__((ext_vector_type(4)));
typedef unsigned u32x4 __attribute__((ext_vector_type(4)));
constexpr int BM = 256, BK = 64, HALF = 128, HTB = HALF * BK * 2  , STAGE_BYTES = 8 * HTB, NXCD = 8, WGM = 8;

__host__ __device__ __forceinline__ int lds_byte(int r, int c) { const int st = (r >> 4) * 2 + (c >> 5), rr = r & 15, cc = c & 31, ob = rr * 64 + cc * 2; return st * 1024 + (ob ^ (((ob >> 9) & 1) << 5)); }
__host__ __device__ __forceinline__ void stage_rc(int b, int& R, int& C) { const int st = b / 1024, sb = b % 1024, swz = sb ^ (((sb >> 9) & 1) << 5); R = (st >> 1) * 16 + swz / 64; C = (st & 1) * 32 + (swz % 64) / 2; }
__host__ __device__ __forceinline__ int perm32(int rho) { const int n = rho >> 4, i = rho & 15; return 8 * (i >> 2) + 4 * n + (i & 3); }

struct Unit { int pm, pn; };
struct Gemm { const bf16_t* A; const bf16_t* Bt; int M, N, K; };

struct StaticOrder {
    int nM, nN, nwg, G, c;
    __host__ __device__ void init(int M, int N, int G_, int c_) { nM = M / BM; nN = N / BM; nwg = nM * nN; G = G_; c = c_; }
    __host__ __device__ bool next(int i, Unit& u) const {
        const long L = (long)i * G + c; if (L >= nwg) return false;
        int wgid = (int)L; { const int q = nwg / NXCD, r = nwg % NXCD, xcd = wgid % NXCD, off = wgid / NXCD; wgid = (xcd < r ? xcd * (q + 1) : r * (q + 1) + (xcd - r) * q) + off; }
        const int nig = WGM * nN, gid = wgid / nig, fm = gid * WGM, gsz = (nM - fm) < WGM ? (nM - fm) : WGM;
        u.pm = fm + ((wgid % nig) % gsz); u.pn = (wgid % nig) / gsz; return true;
    }
    __device__ __forceinline__ void a_ready(const Unit&) const {}
    __device__ __forceinline__ void done(const Unit&) const {}
};

__device__ __forceinline__ unsigned cvt_pk_bf16(float lo, float hi) { unsigned r; asm volatile("v_cvt_pk_bf16_f32 %0, %1, %2" : "=v"(r) : "v"(lo), "v"(hi)); return r; }
typedef float f32x2 __attribute__((ext_vector_type(2)));
__device__ __forceinline__ f32x2 gelu_pk(f32x2 v) {
    const f32x2 av = __builtin_elementwise_abs(v), d = av * 0.2316418882f + 1.0f;
    f32x2 t; t.x = __builtin_amdgcn_rcpf(d.x); t.y = __builtin_amdgcn_rcpf(d.y);
    f32x2 q = t * 0.5307027145f + (-0.7265760135f); q = q * t + 0.7107068705f; q = q * t + (-0.142248368f); q = q * t + 0.127414796f; q = q * t;
    const f32x2 s = (v * v) * (-0.72134752044f);
    f32x2 e; e.x = __builtin_amdgcn_exp2f(s.x); e.y = __builtin_amdgcn_exp2f(s.y);
    const f32x2 m = v * (q * e), r = v - m;
    f32x2 o; o.x = v.x < 0.f ? m.x : r.x; o.y = v.y < 0.f ? m.y : r.y; return o;
}

template <int ACT  > struct EpiBf16 {
    static constexpr bool PERM = true, AFTER_DRAIN = false; static_assert(ACT == 0 || ACT == 1, "EpiBf16: ACT is 0 (none) or 1 (gelu_pk)");
    bf16_t* O; int ldc; const float* bias; int split_cols; size_t split_stride; float scale0;
    __device__ __forceinline__ void operator()(const f32x4 (&acc)[2][2][4][2], const Unit& u, int wr, int wc, int fr, int fq) const {
        const int row0 = u.pm * BM + wr * 64 + fr; int colt = u.pn * BM; bf16_t* base = O;
        float sc = 1.f; if (split_cols) { const int t = colt / split_cols; base += (size_t)t * split_stride; colt -= t * split_cols; if (t == 0) sc = scale0; }
        const int col0 = colt + wc * 32 + 8 * fq, bcol0 = u.pn * BM + wc * 32 + 8 * fq;
        f32x4 bv[2][2];
#pragma unroll
        for (int bj = 0; bj < 2; ++bj)
#pragma unroll
            for (int n = 0; n < 2; ++n) bv[bj][n] = bias ? *(const f32x4*)(bias + bcol0 + bj * HALF + 4 * n) : (f32x4){0.f, 0.f, 0.f, 0.f};
#pragma unroll
        for (int ai = 0; ai < 2; ++ai)
#pragma unroll
            for (int m = 0; m < 4; ++m) { bf16_t* rowp = base + (size_t)(row0 + ai * HALF + m * 16) * ldc + col0;
#pragma unroll
                for (int bj = 0; bj < 2; ++bj) { f32x4 v0 = acc[ai][bj][m][0] + bv[bj][0], v1 = acc[ai][bj][m][1] + bv[bj][1];
                    if (ACT == 1) { f32x2 a = gelu_pk((f32x2){v0[0], v0[1]}), b = gelu_pk((f32x2){v0[2], v0[3]}), c = gelu_pk((f32x2){v1[0], v1[1]}), d = gelu_pk((f32x2){v1[2], v1[3]});
                        v0 = (f32x4){a.x, a.y, b.x, b.y}; v1 = (f32x4){c.x, c.y, d.x, d.y}; }
                    v0 = v0 * sc; v1 = v1 * sc; u32x4 w; w.x = cvt_pk_bf16(v0[0], v0[1]); w.y = cvt_pk_bf16(v0[2], v0[3]); w.z = cvt_pk_bf16(v1[0], v1[1]); w.w = cvt_pk_bf16(v1[2], v1[3]);
                    *(u32x4*)(rowp + bj * HALF) = w; } }
    }
};
template <class Epi, class Sched, bool ALIGN_EPI = false, bool SP2 = false>
__device__ __forceinline__ void gemm_phase(PG8_LAS unsigned char* lds, const Gemm g, const Sched& S, const Epi& E) {
    const int tid = fresh_tid(), wid = __builtin_amdgcn_readfirstlane(tid >> 6), lane = tid & 63, wr = wid >> 2, wc = wid & 3, fr = lane & 15, fq = lane >> 4;
    const int K = g.K, nt = K / BK;
    unsigned voffA[2], voffB[2];
#pragma unroll
    for (int i = 0; i < 2; ++i) { int R, C; stage_rc(tid * 16 + i * 8192, R, C); const int Rb = Epi::PERM ? ((R & ~31) + perm32(R & 31)) : R;
        voffA[i] = (unsigned)(R * K + C) * 2u; voffB[i] = (unsigned)(Rb * K + C) * 2u; }
    const size_t kstep = (size_t)(BK * 2);
    const size_t hstep = (size_t)HALF * K * 2;
    const size_t tstep = 2 * hstep;
    const unsigned ldsw = (unsigned)wid * 1024u;
    const int aoff = lds_byte(wr * 64 + fr, fq * 8), boff = lds_byte(wc * 32 + fr, fq * 8);
#define PG8_SA(b, h) (((b) * 2 + (h)) * HTB)
#define PG8_SB(b, h) ((4 + (b) * 2 + (h)) * HTB)
#define PG8_STAGE(bufoff, gbase, voff) do { _Pragma("unroll") for (int _i = 0; _i < 2; ++_i) \
        __builtin_amdgcn_global_load_lds((const unsigned*)((const char*)(gbase) + (voff)[_i]), (PG8_LAS unsigned*)(lds + (bufoff) + ldsw + _i * 8192), 16, 0, 0); } while (0)
#define PG8_LDA(dst, b, h) do { _Pragma("unroll") for (int m = 0; m < 4; ++m) _Pragma("unroll") for (int k = 0; k < 2; ++k) dst[m][k] = *(const PG8_LAS bf16x8*)(lds + PG8_SA(b, h) + aoff + m * 2048 + k * 1024); } while (0)
#define PG8_LDB(dst, b, h) do { _Pragma("unroll") for (int n = 0; n < 2; ++n) _Pragma("unroll") for (int k = 0; k < 2; ++k) dst[n][k] = *(const PG8_LAS bf16x8*)(lds + PG8_SB(b, h) + boff + n * 2048 + k * 1024); } while (0)
#define PG8_MMA(ai, bj, At, Bt) do { __builtin_amdgcn_s_setprio(1); _Pragma("unroll") for (int m = 0; m < 4; ++m) _Pragma("unroll") for (int n = 0; n < 2; ++n) _Pragma("unroll") for (int k = 0; k < 2; ++k) \
        acc[ai][bj][m][n] = __builtin_amdgcn_mfma_f32_16x16x32_bf16(Bt[n][k], At[m][k], acc[ai][bj][m][n], 0, 0, 0); __builtin_amdgcn_s_setprio(0); } while (0)
#define PG8_WAIT_V(n) asm volatile("s_waitcnt vmcnt(" #n ")" ::: "memory")
#define PG8_WAIT_L(n) asm volatile("s_waitcnt lgkmcnt(" #n ")" ::: "memory")
#define PG8_BAR __builtin_amdgcn_s_barrier()
#define PG8_SCHED __builtin_amdgcn_sched_barrier(0)
    Unit cur, nxt; int ui = 0;
    if (!S.next(0, cur)) return;
    f32x4 acc[2][2][4][2];
#pragma unroll
    for (int a = 0; a < 2; ++a)
#pragma unroll
        for (int b = 0; b < 2; ++b)
#pragma unroll
            for (int m = 0; m < 4; ++m)
#pragma unroll
                for (int n = 0; n < 2; ++n) acc[a][b][m][n] = (f32x4){0.f, 0.f, 0.f, 0.f};
    bf16x8 At[4][2], B0[2][2], B1[2][2];
    const char* cA = (const char*)g.A + (size_t)cur.pm * tstep; const char* cB = (const char*)g.Bt + (size_t)cur.pn * tstep;
    S.a_ready(cur);
    if constexpr (SP2) {
        PG8_STAGE(PG8_SB(0, 0), cB, voffB); PG8_STAGE(PG8_SB(0, 1), cB + hstep, voffB); PG8_STAGE(PG8_SA(0, 0), cA, voffA); PG8_STAGE(PG8_SA(0, 1), cA + hstep, voffA);
        if (wr == 1) PG8_BAR;
        PG8_WAIT_V(2); PG8_BAR;
        PG8_STAGE(PG8_SB(1, 0), cB + kstep, voffB); PG8_STAGE(PG8_SA(1, 0), cA + kstep, voffA); PG8_STAGE(PG8_SB(1, 1), cB + hstep + kstep, voffB);
        PG8_WAIT_V(6); PG8_BAR;
    } else {
        PG8_STAGE(PG8_SB(0, 0), cB, voffB); PG8_STAGE(PG8_SA(0, 0), cA, voffA); PG8_STAGE(PG8_SB(0, 1), cB + hstep, voffB); PG8_STAGE(PG8_SA(0, 1), cA + hstep, voffA);
        if (wr == 1) PG8_BAR;
        PG8_WAIT_V(4); PG8_BAR;
        PG8_STAGE(PG8_SB(1, 0), cB + kstep, voffB); PG8_STAGE(PG8_SA(1, 0), cA + kstep, voffA); PG8_STAGE(PG8_SB(1, 1), cB + hstep + kstep, voffB);
        PG8_WAIT_V(6); PG8_BAR;
    }
    for (;;) {
        const bool has_next = S.next(ui + 1, nxt);
        const char* nA = has_next ? (const char*)g.A + (size_t)nxt.pm * tstep : cA; const char* nB = has_next ? (const char*)g.Bt + (size_t)nxt.pn * tstep : cB;
        for (int t = 0; t < nt; t += 2) {
            const bool last = (t == nt - 2);
            const char* a1 = cA + (size_t)(t + 1) * kstep;
            const char* a2 = last ? nA : cA + (size_t)(t + 2) * kstep; const char* b2 = last ? nB : cB + (size_t)(t + 2) * kstep;
            const char* a3 = a2 + kstep; const char* b3 = b2 + kstep;
            if (last && has_next) S.a_ready(nxt);
            if constexpr (SP2) {
            PG8_LDB(B0, 0, 0); PG8_LDB(B1, 0, 1); PG8_SCHED; PG8_LDA(At, 0, 0); PG8_STAGE(PG8_SA(1, 1), a1 + hstep, voffA);
            PG8_WAIT_V(8); PG8_WAIT_L(0); PG8_BAR; PG8_MMA(0, 0, At, B0); PG8_MMA(0, 1, At, B1); PG8_BAR; PG8_SCHED;
            PG8_LDA(At, 0, 1); PG8_STAGE(PG8_SB(0, 0), b2, voffB); PG8_STAGE(PG8_SB(0, 1), b2 + hstep, voffB); PG8_STAGE(PG8_SA(0, 0), a2, voffA);
            PG8_WAIT_V(8); PG8_WAIT_L(0); PG8_BAR; PG8_MMA(1, 0, At, B0); PG8_MMA(1, 1, At, B1); PG8_BAR; PG8_SCHED;
            PG8_LDB(B0, 1, 0); PG8_LDB(B1, 1, 1); PG8_SCHED; PG8_LDA(At, 1, 0); PG8_STAGE(PG8_SA(0, 1), a2 + hstep, voffA);
            PG8_WAIT_V(8); PG8_WAIT_L(0); PG8_BAR; PG8_MMA(0, 0, At, B0); PG8_MMA(0, 1, At, B1); PG8_BAR; PG8_SCHED;
            PG8_LDA(At, 1, 1); PG8_STAGE(PG8_SB(1, 0), b3, voffB); PG8_STAGE(PG8_SB(1, 1), b3 + hstep, voffB); PG8_STAGE(PG8_SA(1, 0), a3, voffA);
            PG8_WAIT_V(8); PG8_WAIT_L(0); PG8_BAR; PG8_MMA(1, 0, At, B0); PG8_MMA(1, 1, At, B1); PG8_BAR; PG8_SCHED;
            } else {
            PG8_LDB(B0, 0, 0); PG8_SCHED; PG8_LDA(At, 0, 0); PG8_STAGE(PG8_SA(1, 1), a1 + hstep, voffA);
            PG8_WAIT_L(8); PG8_BAR; PG8_WAIT_L(0); PG8_MMA(0, 0, At, B0); PG8_BAR; PG8_SCHED;
            PG8_LDB(B1, 0, 1); PG8_STAGE(PG8_SB(0, 0), b2, voffB);
            PG8_BAR; PG8_WAIT_L(0); PG8_MMA(0, 1, At, B1); PG8_BAR;
            PG8_LDA(At, 0, 1); PG8_STAGE(PG8_SA(0, 0), a2, voffA);
            PG8_BAR; PG8_WAIT_L(0); PG8_MMA(1, 0, At, B0); PG8_BAR; PG8_SCHED;
            PG8_STAGE(PG8_SB(0, 1), b2 + hstep, voffB);
            PG8_WAIT_V(6); PG8_BAR; PG8_MMA(1, 1, At, B1); PG8_BAR;
            PG8_LDB(B0, 1, 0); PG8_SCHED; PG8_LDA(At, 1, 0); PG8_STAGE(PG8_SA(0, 1), a2 + hstep, voffA);
            PG8_WAIT_L(8); PG8_BAR; PG8_WAIT_L(0); PG8_MMA(0, 0, At, B0); PG8_BAR; PG8_SCHED;
            PG8_LDB(B1, 1, 1); PG8_STAGE(PG8_SB(1, 0), b3, voffB);
            PG8_BAR; PG8_WAIT_L(0); PG8_MMA(0, 1, At, B1); PG8_BAR;
            PG8_LDA(At, 1, 1); PG8_STAGE(PG8_SA(1, 0), a3, voffA);
            PG8_BAR; PG8_WAIT_L(0); PG8_MMA(1, 0, At, B0); PG8_BAR; PG8_SCHED;
            PG8_STAGE(PG8_SB(1, 1), b3 + hstep, voffB);
            PG8_WAIT_V(6); PG8_BAR; PG8_MMA(1, 1, At, B1); PG8_BAR;
            }
        }
        if constexpr (ALIGN_EPI) { if (wr == 0) PG8_BAR; }
        if constexpr (!Epi::AFTER_DRAIN) { E(acc, cur, wr, wc, fr, fq); S.done(cur); }
        if (!has_next) break;
#pragma unroll
        for (int a = 0; a < 2; ++a)
#pragma unroll
            for (int b = 0; b < 2; ++b)
#pragma unroll
                for (int m = 0; m < 4; ++m)
#pragma unroll
                    for (int n = 0; n < 2; ++n) acc[a][b][m][n] = (f32x4){0.f, 0.f, 0.f, 0.f};
        cur = nxt; cA = nA; cB = nB; ++ui;
        if constexpr (ALIGN_EPI) { if (wr == 1) PG8_BAR; }
    }
    PG8_WAIT_V(0);
    if constexpr (!ALIGN_EPI) { if (wr == 0) PG8_BAR; }
    PG8_BAR;
    if constexpr (Epi::AFTER_DRAIN) { E.fused(acc, cur, wr, wc, fr, fq, lds, wid, lane); S.done(cur); }
#undef PG8_SA
#undef PG8_SB
#undef PG8_STAGE
#undef PG8_LDA
#undef PG8_LDB
#undef PG8_MMA
#undef PG8_WAIT_V
#undef PG8_WAIT_L
#undef PG8_BAR
#undef PG8_SCHED
}
}

#ifndef PG8_SP2
#define PG8_SP2 true
#endif
#ifndef PG8_ALIGN
#define PG8_ALIGN true
#endif
#include <hip/hip_bf16.h>
#include <cmath>
namespace attn_body {
using bf16=__hip_bfloat16;
using bf16x8=__attribute__((ext_vector_type(8)))short;
using s16x4=__attribute__((ext_vector_type(4)))short;
using f32x16=__attribute__((ext_vector_type(16)))float;
using u32x4=__attribute__((ext_vector_type(4)))unsigned;
constexpr int SEQ=4096,D=64;
constexpr int NW=8,QBLK=32,QB=QBLK*NW,KVBLK=64,NQB=SEQ/QB;
constexpr int ATTN_UNIT_ROWS=QB;
__device__ __forceinline__ int crow(int r,int hi){return (r&3)+8*(r>>2)+4*hi;}
#define SBAR() __builtin_amdgcn_sched_barrier(0)
constexpr int NSLOT=3, SLOTB=8192;
constexpr int LDS_K=0, LDS_V=NSLOT*SLOTB, LDS_WS=2*NSLOT*SLOTB, LDS_OST=LDS_WS+NW*64*4, LDS_BYTES=LDS_OST+NW*4096;
constexpr int LDS_GST=LDS_BYTES;
constexpr float C2=0.125f*1.4426950408889634f;
__device__ __forceinline__ void glds16(const void*gsrc,unsigned lds_dst){unsigned keep;
  asm volatile("s_mov_b32 %0, m0\n\ts_mov_b32 m0, %2\n\ts_nop 0\n\tglobal_load_lds_dwordx4 %1, off\n\ts_mov_b32 m0, %0":"=&s"(keep):"v"(gsrc),"s"(lds_dst):"memory");}
__device__ __forceinline__ float max3f(float a,float b,float c){float r;asm("v_max3_f32 %0, %1, %2, %3":"=v"(r):"v"(a),"v"(b),"v"(c));return r;}
__device__ __forceinline__ float max2f(float a,float b){float r;asm("v_max_f32_e32 %0, %1, %2":"=v"(r):"v"(a),"v"(b));return r;}
__device__ __forceinline__ float fadd_s(float a,float b){float r;asm("v_add_f32_e32 %0, %1, %2":"=v"(r):"v"(a),"v"(b));return r;}
__device__ __forceinline__ float fsub_s(float a,float b){float r;asm("v_sub_f32_e32 %0, %1, %2":"=v"(r):"v"(a),"v"(b));return r;}
typedef float f32x2_t __attribute__((ext_vector_type(2))); typedef __bf16 bf16x2_t __attribute__((ext_vector_type(2)));
__device__ __forceinline__ unsigned cvtpk_s(float lo,float hi){f32x2_t v={lo,hi};bf16x2_t b=__builtin_convertvector(v,bf16x2_t);return __builtin_bit_cast(unsigned,b);}
#define WAIT_BAR(N) asm volatile("s_waitcnt vmcnt(" #N ") lgkmcnt(0)\n\ts_barrier":::"memory")

template<int ND0> __device__ __forceinline__ void qkt(f32x16&p0,f32x16&p1,const char*Kslot,const bf16x8*qr,const f32x16&negm,int r32,int hi){
  const char*kb=Kslot+hi*1024+r32*16;
  #pragma unroll
  for(int d0=0;d0<ND0;++d0){
    const bf16x8 b0=*reinterpret_cast<const bf16x8*>(kb+d0*2048);
    const bf16x8 b1=*reinterpret_cast<const bf16x8*>(kb+d0*2048+512);
    if(d0==0){p0=__builtin_amdgcn_mfma_f32_32x32x16_bf16(b0,qr[0],negm,0,0,0);p1=__builtin_amdgcn_mfma_f32_32x32x16_bf16(b1,qr[0],negm,0,0,0);}
    else{p0=__builtin_amdgcn_mfma_f32_32x32x16_bf16(b0,qr[d0],p0,0,0,0);p1=__builtin_amdgcn_mfma_f32_32x32x16_bf16(b1,qr[d0],p1,0,0,0);}}
}
typedef __attribute__((address_space(3))) const char* lds_cptr;
typedef short v4i16_t __attribute__((ext_vector_type(4)));
__device__ __forceinline__ void kload8(bf16x8*kf,lds_cptr kp){
  kf[0]=*(const __attribute__((address_space(3))) bf16x8*)(kp);      kf[1]=*(const __attribute__((address_space(3))) bf16x8*)(kp+512);
  kf[2]=*(const __attribute__((address_space(3))) bf16x8*)(kp+2048); kf[3]=*(const __attribute__((address_space(3))) bf16x8*)(kp+2560);
  kf[4]=*(const __attribute__((address_space(3))) bf16x8*)(kp+4096); kf[5]=*(const __attribute__((address_space(3))) bf16x8*)(kp+4608);
  kf[6]=*(const __attribute__((address_space(3))) bf16x8*)(kp+6144); kf[7]=*(const __attribute__((address_space(3))) bf16x8*)(kp+6656);
}
__device__ __forceinline__ void kload2(bf16x8*kf,lds_cptr kp,int j){ kf[2*j]=*(const __attribute__((address_space(3))) bf16x8*)(kp+j*2048); kf[2*j+1]=*(const __attribute__((address_space(3))) bf16x8*)(kp+j*2048+512); }
__device__ __forceinline__ s16x4 vtr(lds_cptr p){ return __builtin_bit_cast(s16x4,__builtin_amdgcn_ds_read_tr16_b64_v4i16((__attribute__((address_space(3))) v4i16_t*)p)); }
__device__ __forceinline__ float rowmax(const f32x16&p0,const f32x16&p1){
  float a=max3f(p0[0],p0[1],p1[0]),b=max3f(p0[2],p0[3],p1[1]);a=max3f(a,p1[2],p1[3]);
  #pragma unroll
  for(int r=4;r<16;r+=4){a=max3f(a,p0[r],p0[r+1]);b=max3f(b,p0[r+2],p0[r+3]);a=max3f(a,p1[r],p1[r+1]);b=max3f(b,p1[r+2],p1[r+3]);}
  const float m=max2f(a,b);
  auto rr=__builtin_amdgcn_permlane32_swap(__float_as_uint(m),__float_as_uint(m),false,false);
  return max2f(__uint_as_float(rr[0]),__uint_as_float(rr[1]));
}
__device__ __forceinline__ void pv(f32x16*o,int vb,bf16x8 pa0,bf16x8 pa1,bf16x8 pa2,bf16x8 pa3){
  #pragma unroll
  for(int d0=0;d0<2;++d0){s16x4 lo[4],hi[4];
    #pragma unroll
    for(int ks=0;ks<4;++ks){
      asm volatile("ds_read_b64_tr_b16 %0,%1 offset:%c2":"=&v"(lo[ks]):"v"(vb),"i"(d0*4096+ks*1024):"memory");
      asm volatile("ds_read_b64_tr_b16 %0,%1 offset:%c2":"=&v"(hi[ks]):"v"(vb),"i"(d0*4096+ks*1024+512):"memory");}
    asm volatile("s_waitcnt lgkmcnt(0)":::"memory");SBAR();
    #define PK(k) (bf16x8){lo[k][0],lo[k][1],lo[k][2],lo[k][3],hi[k][0],hi[k][1],hi[k][2],hi[k][3]}
    o[d0]=__builtin_amdgcn_mfma_f32_32x32x16_bf16(pa0,PK(0),o[d0],0,0,0);
    o[d0]=__builtin_amdgcn_mfma_f32_32x32x16_bf16(pa1,PK(1),o[d0],0,0,0);
    o[d0]=__builtin_amdgcn_mfma_f32_32x32x16_bf16(pa2,PK(2),o[d0],0,0,0);
    o[d0]=__builtin_amdgcn_mfma_f32_32x32x16_bf16(pa3,PK(3),o[d0],0,0,0);
    #undef PK
  }
}

#ifndef ATTN_STORE16
#define ATTN_STORE16(p,v) (*(u32x4*)(p)=(v))
#endif
template<int THRL,bool FIXREF,bool HALFK> __device__ __forceinline__ void attn_unit(float mref,long rowbase,int q0,const bf16*Qh,int PQ,const bf16*__restrict__ Kh_,int PK,const bf16*__restrict__ Vh_,int PV,bf16*Oh,int PO,const bf16*Gh,int PG,u32x4(&okeep)[4],int omode,float lam,float oml,const float*subln,char*shm){
  const int tid=fresh_tid(),lane=tid&63,r32=lane&31,hi=lane>>5; const int wid=__builtin_amdgcn_readfirstlane(tid>>6);
  const bf16*Qw=Qh+(rowbase+q0+wid*QBLK)*PQ;
  const bf16*Kh=Kh_+rowbase*PK,*Vh=Vh_+rowbase*PV;
  const unsigned lds0=(unsigned)(uintptr_t)shm;
  float*wsf=(float*)(shm+LDS_WS)+wid*64;
  const bf16*ksrc=Kh+(long)lane*PK+wid*8;
  const bf16*vsrc=Vh+(long)(16*(wid&3)+(lane>>2))*PV+(wid>>2)*32+(lane&3)*8;
  const unsigned kdst=lds0+LDS_K+wid*1024, vdst=lds0+LDS_V+wid*1024;
  #define DMA_K(t,slot) glds16(ksrc+(long)(t)*KVBLK*PK,(unsigned)__builtin_amdgcn_readfirstlane(kdst+(slot)))
  #define DMA_V(t,slot) glds16(vsrc+(long)(t)*KVBLK*PV,(unsigned)__builtin_amdgcn_readfirstlane(vdst+(slot)))
  const int vb0=(int)(lds0+LDS_V)+((lane>>4)&1)*32+(lane&3)*8+(4*hi+((lane&15)>>2))*64;
  const char*Kbase=shm+LDS_K; bf16x8 kf[8];
  const lds_cptr shm3=(lds_cptr)shm; const lds_cptr kp0=shm3+LDS_K+hi*1024+r32*16; const lds_cptr vp0=shm3+LDS_V+((lane>>4)&1)*32+(lane&3)*8+(4*hi+((lane&15)>>2))*64;
  constexpr int NT=SEQ/KVBLK;
  if(Gh){ const bf16*Gw=Gh+(rowbase+q0+wid*QBLK)*PG;
    #pragma unroll
    for(int i=0;i<4;++i) glds16(Gw+(long)(i*8+(lane>>3))*PG+(lane&7)*8,(unsigned)__builtin_amdgcn_readfirstlane(lds0+LDS_GST+wid*4096+i*1024)); }
  DMA_K(0,0);DMA_V(0,0);DMA_K(1,SLOTB);
  bf16x8 qr[4];
  #pragma unroll
  for(int d0=0;d0<4;++d0)qr[d0]=*reinterpret_cast<const bf16x8*>(&Qw[(long)r32*PQ+d0*16+hi*8]);
  float mhat=0.f,l_reg=0.f;f32x16 o[2];o[0]=f32x16{};o[1]=f32x16{};f32x16 negm=f32x16{};
  if constexpr(FIXREF){ mhat=mref; _Pragma("unroll") for(int r=0;r<16;++r)negm[r]=-mref; }
  asm volatile("":"+v"(negm));
  #define CMASK(P0,P1,t) do{}while(0)
  bool resc=false;
  #define START(P0,P1) do{ resc=false; \
    if constexpr(!FIXREF){ const float rm=rowmax(P0,P1); const float dl=rm; mhat=fadd_s(mhat,dl); \
      _Pragma("unroll") for(int r=0;r<16;++r){P0[r]=fsub_s(P0[r],dl);P1[r]=fsub_s(P1[r],dl);} \
      _Pragma("unroll") for(int r=0;r<16;++r)negm[r]=-mhat; asm volatile("":"+v"(negm)); } \
    _Pragma("unroll") for(int r=0;r<16;++r)P0[r]=__builtin_amdgcn_exp2f(P0[r]); }while(0)
  #define RESC() do{ if(!FIXREF&&resc){ asm volatile("s_waitcnt lgkmcnt(0)":::"memory"); \
      _Pragma("unroll") for(int d_=0;d_<2;++d_) _Pragma("unroll") for(int r=0;r<16;++r)o[d_][r]*=wsf[crow(r,hi)]; } }while(0)
  f32x16 pA0,pA1,pB0,pB1;
  int sl_prev=0,sl_cur=0,sl_next=SLOTB;
  #define ROT() do{sl_prev=sl_cur;sl_cur=sl_next;sl_next=(sl_next==(NSLOT-1)*SLOTB)?0:sl_next+SLOTB;}while(0)
  DMA_K(2,2*SLOTB);
  WAIT_BAR(3);
  qkt<HALFK?2:4>(pA0,pA1,Kbase,qr,negm,r32,hi);asm volatile("s_nop 15\n\ts_nop 7":"+v"(pA0),"+v"(pA1));CMASK(pA0,pA1,0);
  START(pA0,pA1);
  _Pragma("unroll") for(int r=0;r<16;++r)pA1[r]=__builtin_amdgcn_exp2f(pA1[r]);
  WAIT_BAR(0);
  DMA_K(3,0);DMA_V(1,SLOTB);
  ROT();
  if constexpr(HALFK){ kload2(kf,kp0+sl_cur,0); kload2(kf,kp0+sl_cur,1); } else kload8(kf,kp0+sl_cur);
  WAIT_BAR(2);
  s16x4 vlo[8],vhi[8]; u32x4 pw0,pw1,pw2,pw3;
  #define PKW(P,B) cvtpk_s(P[B],P[B+1])
  #define PAF(k) __builtin_bit_cast(bf16x8,pw##k)
  #define VFR(i) (bf16x8){vlo[i][0],vlo[i][1],vlo[i][2],vlo[i][3],vhi[i][0],vhi[i][1],vhi[i][2],vhi[i][3]}
  #define PIN(x) asm volatile("":"+v"(x))
  #define MX3(a,b,c) __builtin_fmaxf(__builtin_fmaxf((a),(b)),(c))
  #define GAPA(MF,A0,A1,A2,A3,W0,W1,PW) do{ MF; sacc+=A0; sacc+=A1; sacc+=A2; sacc+=A3; PIN(sacc); W0; W1; PIN(PW); SBAR(); }while(0)
  #define EX(v) __builtin_amdgcn_exp2f(v)
  #define GAPB(MF,X,B) do{ MF; X[B]=EX(X[B]); X[B+1]=EX(X[B+1]); X[B+2]=EX(X[B+2]); X[B+3]=EX(X[B+3]); PIN(X); SBAR(); }while(0)
  #define VRD(i) do{ vlo[i]=vtr(vp_+(((i)>>2)*4096+((i)&3)*1024)); vhi[i]=vtr(vp_+(((i)>>2)*4096+((i)&3)*1024+512)); }while(0)
  #define KRD(G,j) do{ if(G){ kload2(kf,kp0+sl_next,j); SBAR(); } }while(0)
  #define STEP(C0,C1,P0,P1,t,GK,GV,GL) do{ SBAR(); \
    const lds_cptr vp_=vp0+sl_prev; \
    VRD(0); SBAR(); float sacc=(P0[0]+P0[1]); \
    GAPA(C0=__builtin_amdgcn_mfma_f32_32x32x16_bf16(kf[0],qr[0],negm,0,0,0), P0[2],P0[3],P0[4],P0[5],     pw0[0]=PKW(P0,0), pw0[1]=PKW(P0,2), pw0); \
    VRD(4); SBAR(); GAPA(C1=__builtin_amdgcn_mfma_f32_32x32x16_bf16(kf[1],qr[0],negm,0,0,0), P0[6],P0[7],P0[8],P0[9],     pw0[2]=PKW(P0,4), pw0[3]=PKW(P0,6), pw0); \
    VRD(1); SBAR(); GAPA(C0=__builtin_amdgcn_mfma_f32_32x32x16_bf16(kf[2],qr[1],C0,0,0,0),   P0[10],P0[11],P0[12],P0[13], pw1[0]=PKW(P0,8), pw1[1]=PKW(P0,10), pw1); \
    VRD(5); SBAR(); GAPA(C1=__builtin_amdgcn_mfma_f32_32x32x16_bf16(kf[3],qr[1],C1,0,0,0),   P0[14],P0[15],P1[0],P1[1],   pw1[2]=PKW(P0,12),pw1[3]=PKW(P0,14), pw1); \
    VRD(2); SBAR(); GAPA(if constexpr(!HALFK) C0=__builtin_amdgcn_mfma_f32_32x32x16_bf16(kf[4],qr[2],C0,0,0,0),   P1[2],P1[3],P1[4],P1[5],     pw2[0]=PKW(P1,0), pw2[1]=PKW(P1,2), pw2); \
    VRD(6); SBAR(); GAPA(if constexpr(!HALFK) C1=__builtin_amdgcn_mfma_f32_32x32x16_bf16(kf[5],qr[2],C1,0,0,0),   P1[6],P1[7],P1[8],P1[9],     pw2[2]=PKW(P1,4), pw2[3]=PKW(P1,6), pw2); \
    VRD(3); SBAR(); GAPA(if constexpr(!HALFK) C0=__builtin_amdgcn_mfma_f32_32x32x16_bf16(kf[6],qr[3],C0,0,0,0),   P1[10],P1[11],P1[12],P1[13], pw3[0]=PKW(P1,8), pw3[1]=PKW(P1,10), pw3); \
    VRD(7); SBAR(); GAPA(if constexpr(!HALFK) C1=__builtin_amdgcn_mfma_f32_32x32x16_bf16(kf[7],qr[3],C1,0,0,0),   P1[14],P1[15],0.f,0.f,       pw3[2]=PKW(P1,12),pw3[3]=PKW(P1,14), pw3); \
    l_reg+=sacc; \
    if(GK){DMA_K((t)+3,sl_cur);} if(GV){DMA_V((t)+1,sl_next);} \
    CMASK(C0,C1,t); \
    if constexpr(!FIXREF){ float a=MX3(C0[0],C0[1],C1[0]),b=MX3(C0[2],C0[3],C1[1]); a=MX3(a,C1[2],C1[3]); \
      _Pragma("unroll") for(int r=4;r<16;r+=4){a=MX3(a,C0[r],C0[r+1]);b=MX3(b,C0[r+2],C0[r+3]);a=MX3(a,C1[r],C1[r+1]);b=MX3(b,C1[r+2],C1[r+3]);} \
      float rm=__builtin_fmaxf(a,b); { auto rr=__builtin_amdgcn_permlane32_swap(__float_as_uint(rm),__float_as_uint(rm),false,false); rm=__builtin_fmaxf(__uint_as_float(rr[0]),__uint_as_float(rr[1])); } \
      resc=false; \
      if(__builtin_expect(__any(rm>(float)THRL),0)){ const float dl=__builtin_fmaxf(rm,0.f); mhat+=dl; \
        _Pragma("unroll") for(int r=0;r<16;++r){C0[r]-=dl;C1[r]-=dl;} \
        _Pragma("unroll") for(int r=0;r<16;++r)negm[r]=-mhat; asm volatile("":"+v"(negm)); \
        const float f=__builtin_amdgcn_exp2f(-dl); l_reg*=f; if(hi==0)wsf[r32]=f; resc=true; } } \
    SBAR(); \
    GAPB(o[0]=__builtin_amdgcn_mfma_f32_32x32x16_bf16(PAF(0),VFR(0),o[0],0,0,0), C0,0); \
    GAPB(o[1]=__builtin_amdgcn_mfma_f32_32x32x16_bf16(PAF(0),VFR(4),o[1],0,0,0), C0,4); \
    KRD(GL,0); GAPB(o[0]=__builtin_amdgcn_mfma_f32_32x32x16_bf16(PAF(1),VFR(1),o[0],0,0,0), C0,8); \
    KRD(GL,1); GAPB(o[1]=__builtin_amdgcn_mfma_f32_32x32x16_bf16(PAF(1),VFR(5),o[1],0,0,0), C0,12); \
    KRD((GL)&&!HALFK,2); GAPB(o[0]=__builtin_amdgcn_mfma_f32_32x32x16_bf16(PAF(2),VFR(2),o[0],0,0,0), C1,0); \
    KRD((GL)&&!HALFK,3); GAPB(o[1]=__builtin_amdgcn_mfma_f32_32x32x16_bf16(PAF(2),VFR(6),o[1],0,0,0), C1,4); \
    GAPB(o[0]=__builtin_amdgcn_mfma_f32_32x32x16_bf16(PAF(3),VFR(3),o[0],0,0,0), C1,8); \
    GAPB(o[1]=__builtin_amdgcn_mfma_f32_32x32x16_bf16(PAF(3),VFR(7),o[1],0,0,0), C1,12); \
    }while(0)
  int t=1;
  #undef CMASK
  #define CMASK(P0,P1,t) do{}while(0)
  for(;t+5<NT;t+=2){
    STEP(pB0,pB1,pA0,pA1,t,true,true,true);     WAIT_BAR(2); RESC(); ROT();
    STEP(pA0,pA1,pB0,pB1,t+1,true,true,true);   WAIT_BAR(2); RESC(); ROT();
  }
  #undef CMASK
  #define CMASK(P0,P1,t) do{}while(0)
  #define ENDW(tt) do{ if((tt)+3<NT){WAIT_BAR(2);} else if((tt)+2<NT){WAIT_BAR(1);} else {WAIT_BAR(0);} }while(0)
  for(;t+1<NT;t+=2){
    STEP(pB0,pB1,pA0,pA1,t,(t+3<NT),(t+1<NT),(t+1<NT));       ENDW(t);   RESC(); ROT();
    STEP(pA0,pA1,pB0,pB1,t+1,(t+4<NT),(t+2<NT),(t+2<NT));     ENDW(t+1); RESC(); ROT();
  }
  STEP(pB0,pB1,pA0,pA1,NT-1,false,false,false); RESC();
  { float sacc=pB0[0]+pB0[1]; _Pragma("unroll") for(int r=2;r<16;++r)sacc+=pB0[r]; _Pragma("unroll") for(int r=0;r<16;++r)sacc+=pB1[r]; l_reg+=sacc;
    pw0=(u32x4){PKW(pB0,0),PKW(pB0,2),PKW(pB0,4),PKW(pB0,6)};pw1=(u32x4){PKW(pB0,8),PKW(pB0,10),PKW(pB0,12),PKW(pB0,14)};pw2=(u32x4){PKW(pB1,0),PKW(pB1,2),PKW(pB1,4),PKW(pB1,6)};pw3=(u32x4){PKW(pB1,8),PKW(pB1,10),PKW(pB1,12),PKW(pB1,14)};
    SBAR(); pv(o,vb0+sl_cur,PAF(0),PAF(1),PAF(2),PAF(3)); }
  #undef PKW
  #undef PAF
  #undef VFR
  #undef PIN
  #undef MX3
  #undef GAPA
  #undef GAPB
  #undef EX
  #undef VRD
  #undef KRD
  #undef STEP
  #undef ENDW
  {auto rr=__builtin_amdgcn_permlane32_swap(__float_as_uint(l_reg),__float_as_uint(l_reg),false,false);l_reg=__uint_as_float(rr[0])+__uint_as_float(rr[1]);}
  if(hi==0)wsf[32+r32]=l_reg;asm volatile("s_waitcnt lgkmcnt(0)":::"memory");
  float rli[16];
  #pragma unroll
  for(int r=0;r<16;++r)rli[r]=__builtin_amdgcn_rcpf(wsf[32+crow(r,hi)]);
  bf16*Ow=Oh+(rowbase+q0+wid*QBLK)*PO;
  { bf16*stg=(bf16*)(shm+LDS_OST)+wid*2048;
    #pragma unroll
    for(int r=0;r<16;++r){const int orow=crow(r,hi);
      #pragma unroll
      for(int d0=0;d0<2;++d0)stg[orow*64+d0*32+r32]=__float2bfloat16(o[d0][r]*rli[r]);}
    asm volatile("s_waitcnt lgkmcnt(0)":::"memory");
    if(omode==2){
      u32x4 gv[4]; const char*gst=shm+LDS_GST+wid*4096+lane*16;
      #pragma unroll
      for(int i=0;i<4;++i) gv[i]=*(const u32x4*)(gst+i*1024);
      float sg[8]; { const int ch=lane&7;
        #pragma unroll
        for(int e=0;e<8;++e)sg[e]=subln[ch*8+e]*oml; }
      #pragma unroll
      for(int i=0;i<4;++i){const int row=i*8+(lane>>3),ch=lane&7; u32x4 v=*(const u32x4*)(stg+row*64+ch*8); float d[8]; float ss=0.f;
        #pragma unroll
        for(int k=0;k<4;++k){ d[2*k]=__uint_as_float(okeep[i][k]<<16)-lam*__uint_as_float(v[k]<<16); d[2*k+1]=__uint_as_float(okeep[i][k]&0xffff0000u)-lam*__uint_as_float(v[k]&0xffff0000u); ss+=d[2*k]*d[2*k]+d[2*k+1]*d[2*k+1]; }
        ss+=__shfl_xor(ss,1); ss+=__shfl_xor(ss,2); ss+=__shfl_xor(ss,4);
        const float rstd=rsqrtf(ss*(1.f/64.f)+1e-6f);
        #pragma unroll
        for(int k=0;k<4;++k){ const float g0=__uint_as_float(gv[i][k]<<16),g1=__uint_as_float(gv[i][k]&0xffff0000u);
          v[k]=cvtpk_s(d[2*k]*rstd*sg[2*k]*g0*__builtin_amdgcn_rcpf(1.f+__builtin_amdgcn_exp2f(-1.4426950408889634f*g0)),d[2*k+1]*rstd*sg[2*k+1]*g1*__builtin_amdgcn_rcpf(1.f+__builtin_amdgcn_exp2f(-1.4426950408889634f*g1))); }
        ATTN_STORE16(Ow+(long)row*PO+ch*8,v);} }
    else if(Gh){
      u32x4 gv[4]; const char*gst=shm+LDS_GST+wid*4096+lane*16;
      #pragma unroll
      for(int i=0;i<4;++i) gv[i]=*(const u32x4*)(gst+i*1024);
      #pragma unroll
      for(int i=0;i<4;++i){const int row=i*8+(lane>>3),ch=lane&7; u32x4 v=*(const u32x4*)(stg+row*64+ch*8);
        #pragma unroll
        for(int k=0;k<4;++k){ const float g0=__uint_as_float(gv[i][k]<<16),g1=__uint_as_float(gv[i][k]&0xffff0000u),o0=__uint_as_float(v[k]<<16),o1=__uint_as_float(v[k]&0xffff0000u);
          v[k]=cvtpk_s(o0*g0*__builtin_amdgcn_rcpf(1.f+__builtin_amdgcn_exp2f(-1.4426950408889634f*g0)),o1*g1*__builtin_amdgcn_rcpf(1.f+__builtin_amdgcn_exp2f(-1.4426950408889634f*g1))); }
        ATTN_STORE16(Ow+(long)row*PO+ch*8,v);} }
    else if(omode==1){
    #pragma unroll
    for(int i=0;i<4;++i){const int row=i*8+(lane>>3),ch=lane&7; okeep[i]=*(const u32x4*)(stg+row*64+ch*8);} }
    else{
    #pragma unroll
    for(int i=0;i<4;++i){const int row=i*8+(lane>>3),ch=lane&7; const u32x4 v=*(const u32x4*)(stg+row*64+ch*8); ATTN_STORE16(Ow+(long)row*PO+ch*8,v);} } }
  asm volatile("s_waitcnt lgkmcnt(0)\n\ts_barrier":::"memory");
  #undef DMA_K
  #undef DMA_V
  #undef CMASK
  #undef START
  #undef RESC
  #undef ROT
}
constexpr int ATTN_LDS_BYTES=LDS_BYTES+NW*4096;
#undef SBAR
#undef WAIT_BAR
}
namespace cg = cooperative_groups;
#define GAS __attribute__((address_space(1)))
#define LAS __attribute__((address_space(3)))
typedef unsigned short bf16r;
typedef unsigned v4u __attribute__((ext_vector_type(4)));
typedef unsigned v2u __attribute__((ext_vector_type(2)));
typedef float f32x4 __attribute__((ext_vector_type(4)));
typedef float f32x16 __attribute__((ext_vector_type(16)));
typedef short bf16x8 __attribute__((ext_vector_type(8)));

constexpr int NWAVES = 8, NTHR = 512;
constexpr int BATCH = 8, SEQ = 4096, DMODEL = 1024, DIN = 3840, MROWS = BATCH * SEQ, DEPTH = 2;
constexpr float EPS = 1e-6f;
constexpr int C_AQ = 0, C_AK = 256, C_AV = 384, C_AG = 512, C_BP = 768, C_BG = 1536, C_CQ = 1792, C_CK = 2048, C_CV = 2304, C_CG = 2560, C_DP = 2816, C_DG = 3584;
constexpr size_t MiB = 1u << 20;
constexpr size_t WS_CTL = 0, CTL_ZERO_BYTES = 1 * MiB;
constexpr size_t WS_MOD = 0;
constexpr size_t WS_NORM = 256 * 1024;
constexpr size_t WS_BAR = 512 * 1024;
constexpr int MISC_OFF = 131072 + 320;
constexpr size_t WS_TABSEQ = 1 * MiB;
constexpr size_t WS_TABRC = 1 * MiB + 512 * 1024;
constexpr size_t WS_RG = 2 * MiB;
constexpr size_t WS_WIN = 10 * MiB;
constexpr size_t WS_WOUT = 25 * MiB;
constexpr size_t WS_H = 32 * MiB;
constexpr size_t WS_PROJ = 96 * MiB;
constexpr size_t WS_QA = 336 * MiB;
constexpr size_t WS_KA = 352 * MiB;
constexpr size_t WS_QC = 360 * MiB;
constexpr size_t WS_KC = 392 * MiB;
constexpr size_t WS_ZT = 424 * MiB;
constexpr size_t WS_YT = 440 * MiB;
constexpr size_t WS_OA = 456 * MiB;
constexpr size_t WS_OC = 472 * MiB;
constexpr size_t WS_DELTA = WS_QA;
constexpr size_t WS_RG1 = 504 * MiB;
constexpr size_t WS_END = 512 * MiB;
constexpr int LDS_BYTES = 147456;

struct Params { const float* in[26]; float* out; unsigned char* ws; float inv[16]; float lam_init[2]; int pad[2]; };

typedef const __attribute__((address_space(4))) Params* KParams;
__device__ __forceinline__ KParams fresh_params() { KParams kp = (KParams)__builtin_amdgcn_kernarg_segment_ptr(); asm volatile("" : "+s"(kp)); return kp; }
__device__ __forceinline__ unsigned f2bf(float f) { unsigned u = __builtin_bit_cast(unsigned, f); return (u + 0x7fffu + ((u >> 16) & 1u)) >> 16; }
__device__ __forceinline__ unsigned pk2(float lo, float hi) { return attn_body::cvtpk_s(lo, hi); }
__device__ __forceinline__ float bflo(unsigned w) { return __builtin_bit_cast(float, w << 16); }
__device__ __forceinline__ float bfhi(unsigned w) { return __builtin_bit_cast(float, w & 0xffff0000u); }
__device__ __forceinline__ float bf1(bf16r h) { return __builtin_bit_cast(float, (unsigned)h << 16); }
__device__ __forceinline__ float silu_f(float v) { return v * __builtin_amdgcn_rcpf(1.f + __builtin_amdgcn_exp2f(-1.4426950408889634f * v)); }
#define LDS_WAIT() asm volatile("s_waitcnt lgkmcnt(0)" ::: "memory")
__device__ __forceinline__ float shx(float v, int mask, int lane) { return __builtin_bit_cast(float, __builtin_amdgcn_ds_bpermute((lane ^ mask) << 2, __builtin_bit_cast(int, v))); }

__host__ __device__ __forceinline__ int win_l2p(int l) { return (int)((0xedca96b85741032ULL >> (4 * l)) & 15); }
__host__ __device__ __forceinline__ int win_p2l(int p) { return (int)((0xedc8ba759641032ULL >> (4 * p)) & 15); }
__device__ __forceinline__ int win_row_remap(int n0) {
    if (n0 < 256) { const int h = n0 >> 6, bj = (n0 >> 5) & 1; return 128 * bj + 32 * h; }
    if (n0 < 384) { const int q = n0 - 256, h = q >> 6, bj = (q >> 5) & 1; return 256 + 128 * bj + 32 * h; }
    if (n0 < 512) { const int j = n0 - 384; return j < 64 ? 256 + 64 + j : 256 + 192 + (j - 64); }
    if (n0 >= 2816) {
        const int q = n0 - 2816, a = q >> 8, cc = q & 255, h = cc >> 7, off = cc & 127;
        const int tile = (a == 0 || a == 3) ? 11 + h : 13 + h, bj = (a == 0 || a == 1) ? 0 : 1;
        return 256 * tile + 128 * bj + off; }
    return n0; }
__device__ __forceinline__ bool win_block_plain(int n0) { return !(n0 < 384 || (n0 >= 1024 && n0 < 1536) || (n0 >= 1792 && n0 < 2304)); }
template <bool REMAP> __device__ __forceinline__ void p0_transpose_item(const float* W, int K, int N, bf16r* WT, LAS float* scr, int item, int lane) {
    const int nblk = N / 32, kb = item / nblk, nb = item % nblk, k0 = 64 * kb, n0 = 32 * nb, rl = REMAP ? win_row_remap(n0) : n0, r0 = REMAP ? 256 * win_l2p(rl >> 8) + (rl & 255) : n0;
    const bool slot = REMAP && win_block_plain(n0);
#pragma unroll 8
    for (int i = 0; i < 32; ++i) { const int kk = 2 * i + (lane >> 5); scr[kk * 33 + (lane & 31)] = W[(size_t)(k0 + kk) * N + n0 + (lane & 31)]; }
    LDS_WAIT(); asm volatile("" ::: "memory");
    const int c = lane & 7;
#pragma unroll
    for (int j = 0; j < 4; ++j) { const int n = (lane >> 3) + 8 * j; const LAS float* s = scr + (8 * c) * 33 + n;
        v4u o; o.x = pk2(s[0 * 33], s[1 * 33]); o.y = pk2(s[2 * 33], s[3 * 33]); o.z = pk2(s[4 * 33], s[5 * 33]); o.w = pk2(s[6 * 33], s[7 * 33]);
        const int rn = slot ? (16 * ((n >> 2) & 1) + 4 * (n >> 3) + (n & 3)) : n;
        *(v4u*)(WT + (size_t)(r0 + rn) * K + k0 + 8 * c) = o; }
    LDS_WAIT(); asm volatile("" ::: "memory");
}

__device__ __forceinline__ void phase_prologue(LAS unsigned char* lds, int vcu, int G, bool first) {
    const int tid = fresh_tid(), lane = tid & 63, wave = __builtin_amdgcn_readfirstlane(tid >> 6);
    const KParams P = fresh_params(); unsigned char* ws = P->ws;
    {
        LAS float* scr = (LAS float*)(lds + wave * 16384);
        const int gw = vcu * NWAVES + wave, NGW = G * NWAVES;
        constexpr int I_IN = (DMODEL / 64) * (DIN / 32), I_OUT = (DMODEL / 64) * (DMODEL / 32);
        constexpr int NITEMS = DEPTH * (I_IN + I_OUT);
        for (int it = gw; it < NITEMS; it += NGW) {
            int l = it / (I_IN + I_OUT), r = it % (I_IN + I_OUT);
            if (r < I_IN) p0_transpose_item<true>(P->in[5] + (size_t)l * DMODEL * DIN, DMODEL, DIN, (bf16r*)(ws + WS_WIN) + (size_t)l * DIN * DMODEL, scr, r, lane);
            else p0_transpose_item<false>(P->in[6] + (size_t)l * DMODEL * DMODEL, DMODEL, DMODEL, (bf16r*)(ws + WS_WOUT) + (size_t)l * DMODEL * DMODEL, scr, r - I_IN, lane);
        }
    }
    __syncthreads();
    LAS float* L = (LAS float*)lds;
    for (int it = blockIdx.x; it < 192 + 256; it += G) {
        if (it < 192) {
            const int l = it / 96, r = it % 96, cb = r / 16, kc = r % 16;
            { const int b = tid >> 6, kk = tid & 63; L[b * 64 + kk] = silu_f(P->in[1][b * DMODEL + kc * 64 + kk]); }
            __syncthreads();
            const int j = cb * 512 + tid;
            const float* w = P->in[3] + (size_t)l * DMODEL * 3072 + (size_t)(kc * 64) * 3072 + j;
            float acc[8];
#pragma unroll
            for (int b = 0; b < 8; ++b) acc[b] = 0.f;
#pragma unroll 16
            for (int kk = 0; kk < 64; ++kk) { const float wv = w[(size_t)kk * 3072];
#pragma unroll
                for (int b = 0; b < 8; ++b) acc[b] += L[b * 64 + kk] * wv; }
            const float bb = (kc == 0) ? P->in[4][l * 3072 + j] : 0.f;
            float* mod = (float*)(ws + WS_MOD) + (size_t)l * 8 * 3072 + j;
#pragma unroll
            for (int b = 0; b < 8; ++b) atomicAdd(mod + b * 3072, first ? acc[b] + bb : 0.f);
            __syncthreads();
        } else {
            const int q = it - 192, l = q / 128, t0 = (q % 128) * 32;
            LAS float* emb = L;
            LAS float* h1 = L + 32 * 33;
            LAS float* h2 = h1 + 32 * 64;
            for (int idx = tid; idx < 32 * 33; idx += NTHR) {
                const int p = idx / 33, k = idx % 33; const float t = (float)(t0 + p);
                const float w = (6.2831855f * t) * (1.0f / 4096.0f);
                float v;
                if (k == 0) v = t / 4095.0f;
                else { const int i = (k - 1) & 15; const float fk = 1e-4f + (float)i * ((15.0f - 1e-4f) / 15.0f); const float a = fk * w; v = (k <= 16) ? cosf(a) : -sinf(a); }
                emb[idx] = v;
            }
            __syncthreads();
            const float* w1 = P->in[11] + l * 33 * 64; const float* b1 = P->in[12] + l * 64; const float* fr = P->in[13] + l * 64;
            const float* w2 = P->in[14] + l * 64 * 64; const float* b2 = P->in[15] + l * 64; const float* w3 = P->in[16] + l * 64 * 512;
            {
                const int j = tid & 63, pb = tid >> 6; const float frj = fr[j];
                { float wc[33];
#pragma unroll
                  for (int k = 0; k < 33; ++k) wc[k] = w1[k * 64 + j];
                  const float bj = b1[j];
#pragma unroll 1
                  for (int e = 0; e < 4; ++e) { const int p = pb + 8 * e; float v = bj;
#pragma unroll
                      for (int k = 0; k < 33; ++k) v += emb[p * 33 + k] * wc[k];
                      h1[p * 64 + j] = sinf(frj * v); } }
                __syncthreads();
                { float wc[64];
#pragma unroll
                  for (int k = 0; k < 64; ++k) wc[k] = w2[k * 64 + j];
                  const float bj = b2[j];
#pragma unroll 1
                  for (int e = 0; e < 4; ++e) { const int p = pb + 8 * e; float v = bj;
#pragma unroll
                      for (int k = 0; k < 64; ++k) v += h1[p * 64 + k] * wc[k];
                      h2[p * 64 + j] = sinf(frj * v); } }
                __syncthreads();
            }
            {
                const int ch = tid, c = ch & 255, isb = ch >> 8;
                const float absd = 3.0701134573253945f + (float)c * ((15.350567286626972f - 3.0701134573253945f) / 255.0f);
                bf16r* rg = (bf16r*)(ws + WS_RG) + ((size_t)l * 256 + c) * 8192; bf16r* rg1 = (bf16r*)(ws + WS_RG1) + ((size_t)l * 256 + c) * 8192;
                float nsum = 0.f; float w3c[64];
#pragma unroll
                for (int k = 0; k < 64; ++k) w3c[k] = w3[k * 512 + ch];
#pragma unroll 1
                for (int p = 0; p < 32; ++p) {
                    float o = 0.f;
#pragma unroll
                    for (int k = 0; k < 64; ++k) o += h2[p * 64 + k] * w3c[k];
                    const int t = t0 + p; const float tl = (float)t / 4095.0f;
                    const float v = o * (__expf(-tl * absd) + 0.05f);
                    if (!isb) { rg[4096 - t] = (bf16r)f2bf(v); rg1[4095 - t] = (bf16r)f2bf(v); nsum += fabsf(v); }
                    else if (t > 0) { rg[4096 + t] = (bf16r)f2bf(v); rg1[4095 + t] = (bf16r)f2bf(v); nsum += fabsf(v); }
                }
                if (t0 == 0 && !isb) { rg[0] = 0; rg1[8191] = 0; }
                atomicAdd((float*)(ws + WS_NORM) + l * 256 + c, first ? nsum : 0.f);
            }
            __syncthreads();
        }
    }
    {
        float2* tseq = (float2*)(ws + WS_TABSEQ); float2* trc = (float2*)(ws + WS_TABRC);
        for (int idx = blockIdx.x * NTHR + tid; idx < 4096 * 16 + 64 * 16; idx += G * NTHR) {
            const int e = idx < 65536 ? idx : idx - 65536; const int pos = e >> 4, i = e & 15;
            const float a = (float)pos * P->inv[i];
            const float2 cs = make_float2(cosf(a), sinf(a));
            if (idx < 65536) tseq[e] = cs; else trc[e] = cs;
        }
    }
}

__host__ __device__ __forceinline__ int d0_col(int c) { return c < 384 ? c : c < 896 ? c + 640 : c + 896; }
__device__ __forceinline__ void phase_norm(int l, int vcu, int G) {
    const int tid = fresh_tid(), lane = tid & 63, wave = __builtin_amdgcn_readfirstlane(tid >> 6);
    const KParams P = fresh_params(); unsigned char* ws = P->ws; bf16r* H = (bf16r*)(ws + WS_H);
    const float* xin = P->in[0]; const bf16r* DL = (const bf16r*)(ws + WS_PROJ);
    const float* g = P->in[2] + l * DMODEL; const float* mod = (const float*)(ws + WS_MOD) + (size_t)l * 8 * 3072;
    const int gw = vcu * NWAVES + wave, NGW = G * NWAVES;
    for (int m = gw; m < MROWS; m += NGW) {
        const float* xr = xin + (size_t)m * DMODEL + 8 * lane;
        f32x4 v[2][2]; float s = 0.f;
#pragma unroll
        for (int j = 0; j < 2; ++j) { v[j][0] = *(const f32x4*)(xr + 512 * j); v[j][1] = *(const f32x4*)(xr + 512 * j + 4); }
        if (l > 0) {
            const bf16r* dr = DL + (size_t)m * DIN;
#pragma unroll
            for (int j = 0; j < 2; ++j) { const v4u d = *(const v4u*)(dr + d0_col(512 * j + 8 * lane));
                v[j][0].x += bflo(d.x); v[j][0].y += bfhi(d.x); v[j][0].z += bflo(d.y); v[j][0].w += bfhi(d.y); v[j][1].x += bflo(d.z); v[j][1].y += bfhi(d.z); v[j][1].z += bflo(d.w); v[j][1].w += bfhi(d.w); }
        }
#pragma unroll
        for (int j = 0; j < 2; ++j)
#pragma unroll
            for (int h = 0; h < 2; ++h) s += (v[j][h].x * v[j][h].x + v[j][h].y * v[j][h].y) + (v[j][h].z * v[j][h].z + v[j][h].w * v[j][h].w);
#pragma unroll
        for (int o = 1; o < 64; o <<= 1) s += shx(s, o, lane);
        const float rstd = rsqrtf(s * (1.f / DMODEL) + EPS);
        const float* mb = mod + (m >> 12) * 3072;
#pragma unroll
        for (int j = 0; j < 2; ++j) { const int col = 512 * j + 8 * lane; f32x4 hh[2];
#pragma unroll
            for (int h = 0; h < 2; ++h) { const f32x4 gg = *(const f32x4*)(g + col + 4 * h), sh = *(const f32x4*)(mb + col + 4 * h), sc = *(const f32x4*)(mb + 1024 + col + 4 * h);
                hh[h] = v[j][h] * rstd * gg * (sc + 1.0f) + sh; }
            v4u o; o.x = pk2(hh[0].x, hh[0].y); o.y = pk2(hh[0].z, hh[0].w); o.z = pk2(hh[1].x, hh[1].y); o.w = pk2(hh[1].z, hh[1].w);
            *(v4u*)(H + (size_t)m * DMODEL + col) = o; }
    }
}

__device__ __forceinline__ void unpack8(const v4u w, float (&f)[8]) {
    f[0] = bflo(w.x); f[1] = bfhi(w.x); f[2] = bflo(w.y); f[3] = bfhi(w.y); f[4] = bflo(w.z); f[5] = bfhi(w.z); f[6] = bflo(w.w); f[7] = bfhi(w.w); }
__device__ __forceinline__ v4u pack8(const float (&f)[8]) { v4u o; o.x = pk2(f[0], f[1]); o.y = pk2(f[2], f[3]); o.z = pk2(f[4], f[5]); o.w = pk2(f[6], f[7]); return o; }
constexpr int YTP = 66;
template <int VPL, int HD, bool AXIAL>
__device__ __forceinline__ void qk_norm_rope(float (&v)[VPL], int lane, const float* gain, const float2* tseq_or_row, const float2* tcol, float outscale) {
    const int d0 = (lane * VPL) % HD;
    float ss = 0.f;
#pragma unroll
    for (int e = 0; e < VPL; ++e) ss += v[e] * v[e];
#pragma unroll
    for (int o = 1; o < HD / VPL; o <<= 1) ss += __shfl_xor(ss, o);
    const float rstd = rsqrtf(ss * (1.f / HD) + EPS);
    const int db = d0 & 31; const bool x2 = db >= 16; const int i0 = db & 15;
    const float2* tab = (AXIAL && (d0 & 32)) ? tcol : tseq_or_row;
#pragma unroll
    for (int e = 0; e < VPL; ++e) {
        const float y = v[e] * rstd * gain[d0 + e];
        const float pr = __shfl_xor(y, 16 / VPL);
        const float2 cs = tab[i0 + e];
        v[e] = (x2 ? (y * cs.x + pr * cs.y) : (y * cs.x - pr * cs.y)) * outscale;
    }
}

__device__ __forceinline__ void phase_prep(int l, LAS unsigned char* lds, int G) {
    const int tid = fresh_tid(), lane = tid & 63, wave = __builtin_amdgcn_readfirstlane(tid >> 6);
    const KParams P = fresh_params(); unsigned char* ws = P->ws;
    const bf16r* PROJ = (const bf16r*)(ws + WS_PROJ);
    bf16r* QA = (bf16r*)(ws + WS_QA); bf16r* KA = (bf16r*)(ws + WS_KA); bf16r* QC = (bf16r*)(ws + WS_QC); bf16r* KC = (bf16r*)(ws + WS_KC); bf16r* ZT = (bf16r*)(ws + WS_ZT);
    const float2* tseq = (const float2*)(ws + WS_TABSEQ); const float2* trc = (const float2*)(ws + WS_TABRC);
    const float* aqn = P->in[7] + l * 64; const float* akn = P->in[8] + l * 64; const float* cqn = P->in[18] + l * 32; const float* ckn = P->in[19] + l * 32;
    const float* cw = P->in[9] + l * 3 * 768; const float* cbv = P->in[10] + l * 768;
    constexpr float L2E = 1.4426950408889634f;
    LAS bf16r* zt = (LAS bf16r*)lds;
    for (int tile = blockIdx.x; tile < MROWS / 64; tile += G) {
        const int b = tile >> 6, t0 = (tile & 63) * 64; const size_t row0 = (size_t)tile * 64;
        {
            const int c8 = tid & 31, rgp = tid >> 5, c = 8 * c8, tl0 = 4 * rgp, tb = t0 + tl0;
            const bf16r* base = PROJ + (row0 + tl0) * DIN + C_BP + c;
            v4u xw[6], vw[6];
#pragma unroll
            for (int q = 0; q < 6; ++q) { const int t = tb + q - 1; const bool ok = (t >= 0) && (t < SEQ);
                v4u a = (v4u){0u, 0u, 0u, 0u}, d = a;
                if (ok) { const bf16r* pr = base + (long)(q - 1) * DIN; a = *(const v4u*)(pr + 256); d = *(const v4u*)(pr + 512); }
                xw[q] = a; vw[q] = d; }
#pragma unroll
            for (int r = 0; r < 4; ++r) { float xa[8], xb[8], xc[8], va[8], vb[8], vc[8];
                unpack8(xw[r], xa); unpack8(xw[r + 1], xb); unpack8(xw[r + 2], xc); unpack8(vw[r], va); unpack8(vw[r + 1], vb); unpack8(vw[r + 2], vc);
#pragma unroll
                for (int e = 0; e < 8; ++e) {
                    const float x1 = cw[256 + c + e] * xa[e] + cw[768 + 256 + c + e] * xb[e] + cw[1536 + 256 + c + e] * xc[e] + cbv[256 + c + e];
                    const float v1 = cw[512 + c + e] * va[e] + cw[768 + 512 + c + e] * vb[e] + cw[1536 + 512 + c + e] * vc[e] + cbv[512 + c + e];
                    zt[(c + e) * YTP + tl0 + r] = (bf16r)f2bf(x1 * v1); } }
        }
        __syncthreads();
#pragma unroll 4
        for (int i = 0; i < 16; ++i) { const int c = 32 * wave + 2 * i + (lane >> 5), tl = 2 * (lane & 31);
            const unsigned w = *(const LAS unsigned*)(zt + c * YTP + tl);
            *(unsigned*)(ZT + ((size_t)c * BATCH + b) * SEQ + t0 + tl) = w; }
        __syncthreads();
    }
}

__device__ __forceinline__ int crow_(int r, int hi) { return (r & 3) + 8 * (r >> 2) + 4 * hi; }
constexpr int RG1_LDS = 16384 + 64;
constexpr int ZPITCH = 8208;
__device__ __forceinline__ void phase_hyena(int l, LAS unsigned char* lds, int G) {
    const int tid = fresh_tid(), lane = tid & 63, wave = __builtin_amdgcn_readfirstlane(tid >> 6);
    const KParams P = fresh_params(); unsigned char* ws = P->ws;
    const bf16r* X1T = (const bf16r*)(ws + WS_ZT); const bf16r* VT = (const bf16r*)(ws + WS_OA); bf16r* YT = (bf16r*)(ws + WS_YT);
    const float* cw = P->in[9] + l * 3 * 768; const float* cbv = P->in[10] + l * 768;
    const bf16r* RG = (const bf16r*)(ws + WS_RG) + (size_t)l * 256 * 8192; const bf16r* RG1 = (const bf16r*)(ws + WS_RG1) + (size_t)l * 256 * 8192;
    const float* NORM = (const float*)(ws + WS_NORM) + l * 256; const float* hb = P->in[17] + l * 256;
    LAS unsigned char* Zs = lds; LAS bf16r* rl = (LAS bf16r*)(lds + 8 * ZPITCH);
    const int r32 = lane & 31, hi = lane >> 5;
    for (int c = blockIdx.x; c < 256; c += G) {
        {
            const float wx0 = cw[256 + c], wx1 = cw[768 + 256 + c], wx2 = cw[1536 + 256 + c], bx = cbv[256 + c];
            const float wv0 = cw[512 + c], wv1 = cw[768 + 512 + c], wv2 = cw[1536 + 512 + c], bv = cbv[512 + c];
#pragma unroll
            for (int b = 0; b < 8; ++b) { const bf16r* xr = X1T + ((size_t)c * BATCH + b) * SEQ + tid * 8; const bf16r* vr = VT + ((size_t)c * BATCH + b) * SEQ + tid * 8;
                float xf[10], vf[10]; { float t8[8]; unpack8(*(const v4u*)xr, t8);
#pragma unroll
                    for (int e = 0; e < 8; ++e) xf[e + 1] = t8[e]; unpack8(*(const v4u*)vr, t8);
#pragma unroll
                    for (int e = 0; e < 8; ++e) vf[e + 1] = t8[e]; }
                xf[0] = tid > 0 ? bf1(xr[-1]) : 0.f; vf[0] = tid > 0 ? bf1(vr[-1]) : 0.f; xf[9] = tid < NTHR - 1 ? bf1(xr[8]) : 0.f; vf[9] = tid < NTHR - 1 ? bf1(vr[8]) : 0.f;
                float z[8];
#pragma unroll
                for (int e = 0; e < 8; ++e) z[e] = (wx0 * xf[e] + wx1 * xf[e + 1] + wx2 * xf[e + 2] + bx) * (wv0 * vf[e] + wv1 * vf[e + 1] + wv2 * vf[e + 2] + bv);
                *(LAS v4u*)(Zs + b * ZPITCH + tid * 16) = pack8(z); }
        }
#pragma unroll
        for (int i = 0; i < 2; ++i) { *(LAS v4u*)((LAS unsigned char*)rl + (i * NTHR + tid) * 16) = *(const v4u*)(RG + (size_t)c * 8192 + (i * NTHR + tid) * 8);
            *(LAS v4u*)((LAS unsigned char*)rl + RG1_LDS + (i * NTHR + tid) * 16) = *(const v4u*)(RG1 + (size_t)c * 8192 + (i * NTHR + tid) * 8); }
        __syncthreads();
        const float invn = 1.0f / NORM[c], bias = hb[c];
        f32x16 acc[2][2];
#pragma unroll
        for (int a = 0; a < 2; ++a)
#pragma unroll
            for (int bb = 0; bb < 2; ++bb) acc[a][bb] = f32x16{};
        const int Dlo = (8 * wave - 63) > -63 ? (8 * wave - 63) : -63, Dhi = (8 * wave + 7) < 63 ? (8 * wave + 7) : 63;
        const LAS unsigned char* zb = Zs + (r32 & 7) * ZPITCH + hi * 16;
        const LAS unsigned char* apar = (const LAS unsigned char*)rl + (r32 & 1) * RG1_LDS;
#define HY_BODY(DO0, DO1) do { \
            bf16x8 A6[6]; \
            const LAS unsigned* ap = (const LAS unsigned*)(apar + (4096 - 64 * D - 32 + 8 * hi - r32 - (r32 & 1)) * 2);     \
            _Pragma("unroll") for (int q = 0; q < 6; ++q) { v4u w; w.x = ap[8 * q]; w.y = ap[8 * q + 1]; w.z = ap[8 * q + 2]; w.w = ap[8 * q + 3]; A6[q] = __builtin_bit_cast(bf16x8, w); } \
            bf16x8 Bf[2][4]; \
            _Pragma("unroll") for (int ct = 0; ct < 2; ++ct) { if (ct == 0 ? (DO0) : (DO1)) { const int J = 8 * wave + 4 * ct + (r32 >> 3) - D; const bool ok = (unsigned)J < 64u; \
                _Pragma("unroll") for (int ks = 0; ks < 4; ++ks) { bf16x8 z = bf16x8{}; if (ok) z = *(const LAS bf16x8*)(zb + (64 * J + 16 * ks) * 2); Bf[ct][ks] = z; } } } \
            __builtin_amdgcn_s_setprio(1); \
            _Pragma("unroll") for (int ks = 0; ks < 4; ++ks) _Pragma("unroll") for (int rt = 0; rt < 2; ++rt) _Pragma("unroll") for (int ct = 0; ct < 2; ++ct) \
                if (ct == 0 ? (DO0) : (DO1)) acc[rt][ct] = __builtin_amdgcn_mfma_f32_32x32x16_bf16(A6[ks - 2 * rt + 2], Bf[ct][ks], acc[rt][ct], 0, 0, 0); \
            __builtin_amdgcn_s_setprio(0); } while (0)
        { int D = Dlo;
          for (; D < 8 * wave - 59; ++D) HY_BODY(true, false);
          for (; D <= 8 * wave + 3; ++D) HY_BODY(true, true);
          for (; D <= Dhi; ++D) HY_BODY(false, true); }
#undef HY_BODY
        const int b = r32 & 7;
#pragma unroll
        for (int rt = 0; rt < 2; ++rt)
#pragma unroll
            for (int ct = 0; ct < 2; ++ct) { const int I = 8 * wave + 4 * ct + (r32 >> 3);
#pragma unroll
                for (int k2 = 0; k2 < 2; ++k2) { v2u pk[2];
#pragma unroll
                    for (int rr = 0; rr < 2; ++rr) { const int r4 = 2 * k2 + rr, t = 64 * I + 32 * rt + 8 * r4 + 4 * hi;
                        const v2u zz = *(const LAS v2u*)(Zs + b * ZPITCH + t * 2);
                        const float y0 = acc[rt][ct][4 * r4 + 0] * invn + bias * bflo(zz.x), y1 = acc[rt][ct][4 * r4 + 1] * invn + bias * bfhi(zz.x);
                        const float y2 = acc[rt][ct][4 * r4 + 2] * invn + bias * bflo(zz.y), y3 = acc[rt][ct][4 * r4 + 3] * invn + bias * bfhi(zz.y);
                        pk[rr].x = pk2(y0, y1); pk[rr].y = pk2(y2, y3); }
                    const auto sx = __builtin_amdgcn_permlane32_swap(pk[0].x, pk[1].x, false, false); const auto sy = __builtin_amdgcn_permlane32_swap(pk[0].y, pk[1].y, false, false);
                    v4u o; o.x = sx[0]; o.y = sy[0]; o.z = sx[1]; o.w = sy[1];
                    *(v4u*)(YT + ((size_t)c * BATCH + b) * SEQ + 64 * I + 32 * rt + 16 * k2 + 8 * hi) = o; } }
        __syncthreads();
    }
}

__device__ __forceinline__ void phase_combine(int l, LAS unsigned char* lds, int G) {
    const int tid = fresh_tid(), lane = tid & 63, wave = __builtin_amdgcn_readfirstlane(tid >> 6);
    const KParams P = fresh_params(); unsigned char* ws = P->ws;
    const bf16r* PROJ = (const bf16r*)(ws + WS_PROJ); const bf16r* OC = (const bf16r*)(ws + WS_OC);
    const bf16r* YT = (const bf16r*)(ws + WS_YT); bf16r* Y = (bf16r*)(ws + WS_H);
    const float* cw = P->in[9] + l * 3 * 768; const float* cbv = P->in[10] + l * 768; const float* scw = P->in[25] + l * 3 * 256; const float* subln = P->in[24] + l * 64;
    float lam;
    { float s1 = 0.f, s2 = 0.f;
      for (int i = 0; i < 32; ++i) { s1 += P->in[20][l * 32 + i] * P->in[21][l * 32 + i]; s2 += P->in[22][l * 32 + i] * P->in[23][l * 32 + i]; }
      lam = expf(s1) - expf(s2) + P->lam_init[l]; }
    const float oml = 1.0f - P->lam_init[l];
    LAS bf16r* yt = (LAS bf16r*)lds;
    const int c8 = tid & 31, rgp = tid >> 5, c = 8 * c8;
    for (int tile = blockIdx.x; tile < MROWS / 64; tile += G) {
        const int b = tile >> 6, t0 = (tile & 63) * 64; const size_t row0 = (size_t)tile * 64;
        const int tl0 = 4 * rgp, tb = t0 + tl0;
        const bf16r* base = PROJ + (row0 + tl0) * DIN + c;
        v4u xw[6]; float uw[6][8];
#pragma unroll
        for (int q = 0; q < 6; ++q) { const int t = tb + q - 1; const bool ok = (t >= 0) && (t < SEQ);
            v4u a = (v4u){0u, 0u, 0u, 0u}, g = a;
            if (ok) { const bf16r* pr = base + (long)(q - 1) * DIN; a = *(const v4u*)(pr + C_BP); g = *(const v4u*)(pr + C_DP + 256); }
            xw[q] = a; unpack8(g, uw[q]); }
#pragma unroll 8
        for (int i = 0; i < 16; ++i) { const int cc = 32 * wave + 2 * i + (lane >> 5), tl = 2 * (lane & 31);
            *(LAS unsigned*)(yt + cc * YTP + tl) = *(const unsigned*)(YT + ((size_t)cc * BATCH + b) * SEQ + t0 + tl); }
        __syncthreads();
#pragma unroll
        for (int r = 0; r < 4; ++r) {
            const bf16r* pr = base + (size_t)r * DIN; const size_t row = row0 + tl0 + r;
            bf16r* yrow = Y + row * DMODEL + c;
            float g[8], o[8], y[8];
            { unpack8(*(const v4u*)(pr + C_BG), g); float xa[8], xb[8], xc[8]; unpack8(xw[r], xa); unpack8(xw[r + 1], xb); unpack8(xw[r + 2], xc);
#pragma unroll
              for (int e = 0; e < 8; ++e) { const float x0 = cw[c + e] * xa[e] + cw[768 + c + e] * xb[e] + cw[1536 + c + e] * xc[e] + cbv[c + e];
                  y[e] = silu_f(g[e]) * x0 * bf1(yt[(c + e) * YTP + tl0 + r]); }
              *(v4u*)(yrow + 256) = pack8(y); }
            { unpack8(*(const v4u*)(pr + C_DP), o);
#pragma unroll
              for (int e = 0; e < 8; ++e) y[e] = o[e] * (scw[c + e] * uw[r][e] + scw[256 + c + e] * uw[r + 1][e] + scw[512 + c + e] * uw[r + 2][e]);
              *(v4u*)(yrow + 768) = pack8(y); }
        }
        __syncthreads();
    }
}

struct EpiProj {
    static constexpr bool PERM = false, AFTER_DRAIN = false;
    int l;
    __device__ __forceinline__ static v2u pk4(float a, float b, float c, float d) { v2u o; o.x = pg8::cvt_pk_bf16(a, b); o.y = pg8::cvt_pk_bf16(c, d); return o; }
    __device__ __forceinline__ static void store_pair16(bf16r* blk, int fq, v2u o1, v2u o2) {
        const auto sx = __builtin_amdgcn_permlane16_swap(o1.x, o2.x, false, false); const auto sy = __builtin_amdgcn_permlane16_swap(o1.y, o2.y, false, false);
        v4u w; w.x = sx[0]; w.y = sy[0]; w.z = sx[1]; w.w = sy[1];
        *(v4u*)(blk + ((fq & 1) ? 16 + 4 * (fq - 1) : 4 * fq)) = w;
    }
    __device__ __forceinline__ void head64(const pg8::f32x4 (&acc)[2][2][4][2], int row0, int fq, bf16r* dst, int pitch, int colbase, const float* gain, float scale, const float2* trc) const {
        pg8::f32x4 g[2][2], rcs[2][2];
#pragma unroll
        for (int bj = 0; bj < 2; ++bj) { g[bj][0] = *(const pg8::f32x4*)(gain + 32 * bj + 4 * fq); g[bj][1] = *(const pg8::f32x4*)(gain + 32 * bj + 16 + 4 * fq); }
#pragma unroll
        for (int ai = 0; ai < 2; ++ai) { const float2* tab = trc + (((row0 + ai * 128) & (SEQ - 1)) >> 6) * 16 + 4 * fq; rcs[ai][0] = *(const pg8::f32x4*)tab; rcs[ai][1] = *(const pg8::f32x4*)(tab + 2); }
#pragma unroll
        for (int mh = 0; mh < 2; ++mh) {
            pg8::f32x4 ccs[2][2];
#pragma unroll
            for (int mm = 0; mm < 2; ++mm) { const float2* tab = trc + ((row0 + (2 * mh + mm) * 16) & 63) * 16 + 4 * fq; ccs[mm][0] = *(const pg8::f32x4*)tab; ccs[mm][1] = *(const pg8::f32x4*)(tab + 2); }
            asm volatile("" ::: "memory");
#pragma unroll
        for (int mm = 0; mm < 2; ++mm)
#pragma unroll
            for (int ai = 0; ai < 2; ++ai) { const int m = 2 * mh + mm; const int row = row0 + ai * 128 + m * 16;
                float ss = 0.f;
#pragma unroll
                for (int bj = 0; bj < 2; ++bj)
#pragma unroll
                    for (int n = 0; n < 2; ++n) { const pg8::f32x4 v = acc[ai][bj][m][n]; ss += (v[0] * v[0] + v[1] * v[1]) + (v[2] * v[2] + v[3] * v[3]); }
                ss += __shfl_xor(ss, 16); ss += __shfl_xor(ss, 32);
                const float rstd = rsqrtf(ss * (1.f / 64.f) + EPS);
#pragma unroll
                for (int bj = 0; bj < 2; ++bj) { const pg8::f32x4 cs01 = bj == 0 ? rcs[ai][0] : ccs[mm][0], cs23 = bj == 0 ? rcs[ai][1] : ccs[mm][1];
                    const pg8::f32x4 x1 = acc[ai][bj][m][0] * g[bj][0] * (rstd * scale), x2 = acc[ai][bj][m][1] * g[bj][1] * (rstd * scale);
                    const float c0 = cs01[0], s0 = cs01[1], c1 = cs01[2], s1 = cs01[3], c2 = cs23[0], s2 = cs23[1], c3 = cs23[2], s3 = cs23[3];
                    store_pair16(dst + (size_t)row * pitch + colbase + 32 * bj, fq, pk4(x1[0] * c0 - x2[0] * s0, x1[1] * c1 - x2[1] * s1, x1[2] * c2 - x2[2] * s2, x1[3] * c3 - x2[3] * s3),
                                 pk4(x2[0] * c0 + x1[0] * s0, x2[1] * c1 + x1[1] * s1, x2[2] * c2 + x1[2] * s2, x2[3] * c3 + x1[3] * s3)); } } }
    }
    __device__ __forceinline__ void sub32(const pg8::f32x4 (&acc)[2][2][4][2], int row0, int wc, int fq, bf16r* dst, const float* gain, float scale, const float2* tseq) const {
        const pg8::f32x4 g1 = *(const pg8::f32x4*)(gain + 4 * fq), g2 = *(const pg8::f32x4*)(gain + 16 + 4 * fq);
#pragma unroll
        for (int ai = 0; ai < 2; ++ai) {
            pg8::f32x4 cs[4][2];
#pragma unroll
            for (int m = 0; m < 4; ++m) { const float2* tab = tseq + ((row0 + ai * 128 + m * 16) & (SEQ - 1)) * 16 + 4 * fq; cs[m][0] = *(const pg8::f32x4*)tab; cs[m][1] = *(const pg8::f32x4*)(tab + 2); }
            asm volatile("" ::: "memory");
#pragma unroll
            for (int m = 0; m < 4; ++m) { const int row = row0 + ai * 128 + m * 16;
                const pg8::f32x4 cs01 = cs[m][0], cs23 = cs[m][1];
                const float c0 = cs01[0], s0 = cs01[1], c1 = cs01[2], s1 = cs01[3], c2 = cs23[0], s2 = cs23[1], c3 = cs23[2], s3 = cs23[3];
#pragma unroll
                for (int bj = 0; bj < 2; ++bj) { const pg8::f32x4 a = acc[ai][bj][m][0], b = acc[ai][bj][m][1];
                    float ss = ((a[0] * a[0] + a[1] * a[1]) + (a[2] * a[2] + a[3] * a[3])) + ((b[0] * b[0] + b[1] * b[1]) + (b[2] * b[2] + b[3] * b[3]));
                    ss += __shfl_xor(ss, 16); ss += __shfl_xor(ss, 32);
                    const float rs = rsqrtf(ss * (1.f / 32.f) + EPS) * scale;
                    const pg8::f32x4 x1 = a * g1 * rs, x2 = b * g2 * rs;
                    store_pair16(dst + (size_t)row * 256 + (4 * bj + wc) * 32, fq, pk4(x1[0] * c0 - x2[0] * s0, x1[1] * c1 - x2[1] * s1, x1[2] * c2 - x2[2] * s2, x1[3] * c3 - x2[3] * s3),
                                 pk4(x2[0] * c0 + x1[0] * s0, x2[1] * c1 + x1[1] * s1, x2[2] * c2 + x1[2] * s2, x2[3] * c3 + x1[3] * s3));
                    } } }
    }
    __device__ __forceinline__ void plain(const pg8::f32x4 (&acc)[2][2][4][2], int row0, bf16r* dst0, int off_bj1) const {
#pragma unroll
        for (int ai = 0; ai < 2; ++ai)
#pragma unroll
            for (int m = 0; m < 4; ++m) { bf16r* d = dst0 + (size_t)(row0 + ai * 128 + m * 16) * DIN;
#pragma unroll
                for (int bj = 0; bj < 2; ++bj) { const pg8::f32x4 v0 = acc[ai][bj][m][0], v1 = acc[ai][bj][m][1];
                    v4u w; w.x = pg8::cvt_pk_bf16(v0[0], v0[1]); w.y = pg8::cvt_pk_bf16(v0[2], v0[3]); w.z = pg8::cvt_pk_bf16(v1[0], v1[1]); w.w = pg8::cvt_pk_bf16(v1[2], v1[3]);
                    *(v4u*)(d + bj * off_bj1) = w; } }
    }
    template <bool SILU> __device__ __forceinline__ void pairmul(const pg8::f32x4 (&acc)[2][2][4][2], int row0, bf16r* dst0) const {
#pragma unroll
        for (int ai = 0; ai < 2; ++ai)
#pragma unroll
            for (int m = 0; m < 4; ++m) { float y[8];
#pragma unroll
                for (int n = 0; n < 2; ++n)
#pragma unroll
                    for (int e = 0; e < 4; ++e) { const float p = acc[ai][0][m][n][e], q = acc[ai][1][m][n][e]; y[4 * n + e] = SILU ? silu_f(q) * p : p * q; }
                *(v4u*)(dst0 + (size_t)(row0 + ai * 128 + m * 16) * DIN) = pack8(y); }
    }
    __device__ __forceinline__ static v2u quadT(const pg8::f32x4 v, bool o1, bool o2) {
        const float p0 = __shfl_xor(o1 ? v[0] : v[1], 1), p1 = __shfl_xor(o1 ? v[2] : v[3], 1);
        const float a0 = o1 ? p0 : v[0], a1 = o1 ? v[1] : p0, a2 = o1 ? p1 : v[2], a3 = o1 ? v[3] : p1;
        const float r0 = __shfl_xor(o2 ? a0 : a2, 2), r1 = __shfl_xor(o2 ? a1 : a3, 2);
        return pk4(o2 ? r0 : a0, o2 ? r1 : a1, o2 ? a2 : r0, o2 ? a3 : r1);
    }
    __device__ __forceinline__ void transposed(const pg8::f32x4 (&acc)[2][2][4][2], int row0, int fr, bf16r* dstT, int cbase) const {
        const int q = fr & 3; const bool o1 = q & 1, o2 = q & 2, up = fr & 4;
#pragma unroll
        for (int ai = 0; ai < 2; ++ai)
#pragma unroll
            for (int m = 0; m < 4; ++m) { const int row = row0 + ai * 128 + m * 16, b = row >> 12, t8 = (row & (SEQ - 1)) & ~7;
#pragma unroll
                for (int bj = 0; bj < 2; ++bj) { const v2u k0 = quadT(acc[ai][bj][m][0], o1, o2), k1 = quadT(acc[ai][bj][m][1], o1, o2);
                    const unsigned rx = __shfl_xor(up ? k0.x : k1.x, 4), ry = __shfl_xor(up ? k0.y : k1.y, 4);
                    v4u w; if (up) { w.x = rx; w.y = ry; w.z = k1.x; w.w = k1.y; } else { w.x = k0.x; w.y = k0.y; w.z = rx; w.w = ry; }
                    const int cc = 128 * bj + cbase + (up ? 16 : 0) + q;
                    *(v4u*)(dstT + ((size_t)cc * BATCH + b) * SEQ + t8) = w; } }
    }
    __device__ __forceinline__ void operator()(const pg8::f32x4 (&acc)[2][2][4][2], const pg8::Unit& u, int wr, int wc, int fr, int fq) const {
        constexpr float L2E = 1.4426950408889634f;
        const int row0 = u.pm * 256 + wr * 64 + fr, pn = win_p2l(u.pn);
        const KParams P = fresh_params(); unsigned char* ws = P->ws;
        bf16r* PROJ = (bf16r*)(ws + WS_PROJ); bf16r* QA = (bf16r*)(ws + WS_QA); bf16r* KA = (bf16r*)(ws + WS_KA); bf16r* QC = (bf16r*)(ws + WS_QC); bf16r* KC = (bf16r*)(ws + WS_KC);
        bf16r* X1T = (bf16r*)(ws + WS_ZT); bf16r* VT = (bf16r*)(ws + WS_OA);
        const float* aqn = P->in[7] + l * 64; const float* akn = P->in[8] + l * 64; const float* cqn = P->in[18] + l * 32; const float* ckn = P->in[19] + l * 32;
        const float2* tseq = (const float2*)(ws + WS_TABSEQ); const float2* trc = (const float2*)(ws + WS_TABRC);
        if (pn == 0) head64(acc, row0, fq, QA, 256, 64 * wc, aqn, 0.125f * L2E, trc);
        else if (pn == 1) { if (wc < 2) head64(acc, row0, fq, KA, 128, 64 * wc, akn, 1.0f, trc);
                            else plain(acc, row0, PROJ + C_AV + 32 * (wc - 2) + 8 * fq, 64); }
        else if (pn == 7) sub32(acc, row0, wc, fq, QC, cqn, 0.17677669529663687f * L2E, tseq);
        else if (pn == 8) sub32(acc, row0, wc, fq, KC, ckn, 1.0f, tseq);
        else if (pn == 11 || pn == 12) pairmul<true>(acc, row0, PROJ + C_DP + 128 * (pn - 11) + 32 * wc + 8 * fq);
        else if (pn == 13 || pn == 14) pairmul<false>(acc, row0, PROJ + C_DP + 256 + 128 * (pn - 13) + 32 * wc + 8 * fq);
        else if (pn == 4) transposed(acc, row0, fr, X1T, 32 * wc + 4 * fq);
        else if (pn == 5) transposed(acc, row0, fr, VT, 32 * wc + 4 * fq);
        else plain(acc, row0, PROJ + pn * 256 + 32 * wc + 8 * fq, 128);
    }
};

struct EpiGateBf16 {
    static constexpr bool PERM = true, AFTER_DRAIN = false;
    pg8::bf16_t* O; const float* gate; int pitch; bool park;
    __device__ __forceinline__ void operator()(const pg8::f32x4 (&acc)[2][2][4][2], const pg8::Unit& u, int wr, int wc, int fr, int fq) const {
        const int row0 = u.pm * 256 + wr * 64 + fr, col0 = u.pn * 256 + wc * 32 + 8 * fq;
        const float* gb = gate + (u.pm >> 4) * 3072 + col0;
        pg8::f32x4 gv[2][2];
#pragma unroll
        for (int bj = 0; bj < 2; ++bj)
#pragma unroll
            for (int n = 0; n < 2; ++n) gv[bj][n] = *(const pg8::f32x4*)(gb + bj * 128 + 4 * n);
        int cmap[2];
#pragma unroll
        for (int bj = 0; bj < 2; ++bj) cmap[bj] = park ? d0_col(col0 + bj * 128) : col0 + bj * 128;
#pragma unroll
        for (int ai = 0; ai < 2; ++ai)
#pragma unroll
            for (int m = 0; m < 4; ++m) { pg8::bf16_t* rowp = O + (size_t)(row0 + ai * 128 + m * 16) * pitch;
#pragma unroll
                for (int bj = 0; bj < 2; ++bj) { const pg8::f32x4 v0 = acc[ai][bj][m][0] * gv[bj][0], v1 = acc[ai][bj][m][1] * gv[bj][1];
                    pg8::u32x4 w; w.x = pg8::cvt_pk_bf16(v0[0], v0[1]); w.y = pg8::cvt_pk_bf16(v0[2], v0[3]); w.z = pg8::cvt_pk_bf16(v1[0], v1[1]); w.w = pg8::cvt_pk_bf16(v1[2], v1[3]);
                    *(pg8::u32x4*)(rowp + cmap[bj]) = w; } }
    }
};

__device__ __forceinline__ void phase_gemm1(int l, LAS unsigned char* lds, int G, int bx) {
    const KParams P = fresh_params(); unsigned char* ws = P->ws;
    pg8::Gemm g{(const pg8::bf16_t*)(ws + WS_H), (const pg8::bf16_t*)(ws + WS_WIN) + (size_t)l * DIN * DMODEL, MROWS, DIN, DMODEL};
    pg8::StaticOrder S; S.init(MROWS, DIN, G, bx);
    EpiProj E{l};
    pg8::gemm_phase<EpiProj, pg8::StaticOrder, PG8_ALIGN, PG8_SP2>(lds, g, S, E);
}
__device__ __forceinline__ void phase_gemm2(int l, LAS unsigned char* lds, int G, int bx) {
    const KParams P = fresh_params(); unsigned char* ws = P->ws;
    pg8::Gemm g{(const pg8::bf16_t*)(ws + WS_H), (const pg8::bf16_t*)(ws + WS_WOUT) + (size_t)l * DMODEL * DMODEL, MROWS, DMODEL, DMODEL};
    pg8::StaticOrder S; S.init(MROWS, DMODEL, G, bx);
    EpiGateBf16 E{(pg8::bf16_t*)(ws + (l == 0 ? WS_PROJ : WS_DELTA)), (const float*)(ws + WS_MOD) + (size_t)l * 8 * 3072 + 2048, l == 0 ? DIN : DMODEL, l == 0};
    pg8::gemm_phase<EpiGateBf16, pg8::StaticOrder, PG8_ALIGN, PG8_SP2>(lds, g, S, E);
}
__device__ __forceinline__ void phase_final(int vcu, int G) {
    const KParams P = fresh_params(); unsigned char* ws = P->ws;
    const int tid = fresh_tid();
    float* out = P->out; const float* xin = P->in[0]; const bf16r* DL = (const bf16r*)(ws + WS_DELTA); const bf16r* D0 = (const bf16r*)(ws + WS_PROJ);
    const unsigned n8 = (unsigned)MROWS * DMODEL / 8;
    for (unsigned i = (unsigned)vcu * NTHR + tid; i < n8; i += (unsigned)G * NTHR) {
        const unsigned row = i >> 7, col = (i & 127) * 8;
        const v4u d = *(const v4u*)(DL + (size_t)i * 8), e = *(const v4u*)(D0 + (size_t)row * DIN + d0_col((int)col));
        f32x4 a = *(const f32x4*)(xin + (size_t)i * 8), b = *(const f32x4*)(xin + (size_t)i * 8 + 4);
        a.x += bflo(d.x) + bflo(e.x); a.y += bfhi(d.x) + bfhi(e.x); a.z += bflo(d.y) + bflo(e.y); a.w += bfhi(d.y) + bfhi(e.y);
        b.x += bflo(d.z) + bflo(e.z); b.y += bfhi(d.z) + bfhi(e.z); b.z += bflo(d.w) + bflo(e.w); b.w += bfhi(d.w) + bfhi(e.w);
        *(f32x4*)(out + (size_t)i * 8) = a; *(f32x4*)(out + (size_t)i * 8 + 4) = b; }
}
__device__ __forceinline__ void phase_attn(int l, char* lds_generic, int vcu, int G) {
    const KParams P = fresh_params(); unsigned char* ws = P->ws;
    using abf = attn_body::bf16;
    float bA, bC;
    { float gq = 0.f, gk = 0.f, cq = 0.f, ck = 0.f;
      for (int i = 0; i < 64; ++i) { gq = fmaxf(gq, fabsf(P->in[7][l * 64 + i])); gk = fmaxf(gk, fabsf(P->in[8][l * 64 + i])); }
      for (int i = 0; i < 32; ++i) { cq = fmaxf(cq, fabsf(P->in[18][l * 32 + i])); ck = fmaxf(ck, fabsf(P->in[19][l * 32 + i])); }
      bA = 64.f * 0.125f * 1.4426950408889634f * 1.03f * gq * gk; bC = 32.f * 0.17677669529663687f * 1.4426950408889634f * 1.03f * cq * ck; }
    const bool fix = (bA < 40.f) && (bC < 40.f);
    float lam;
    { float s1 = 0.f, s2 = 0.f;
      for (int i = 0; i < 32; ++i) { s1 += P->in[20][l * 32 + i] * P->in[21][l * 32 + i]; s2 += P->in[22][l * 32 + i] * P->in[23][l * 32 + i]; }
      lam = expf(s1) - expf(s2) + P->lam_init[l]; }
    const float oml = 1.0f - P->lam_init[l]; const float* subln = P->in[24] + l * 64;
#define ATTN_A_ARGS \
        const int grp = u >> 4, qb = u & 15, b = grp >> 2, h = grp & 3; \
        const abf* Q = (const abf*)(ws + WS_QA) + h * 64; const abf* K = (const abf*)(ws + WS_KA) + (h >> 1) * 64; const abf* V = (const abf*)(ws + WS_PROJ) + C_AV + (h >> 1) * 64; \
        abf* O = (abf*)(ws + WS_H) + h * 64; const abf* Gt = (const abf*)(ws + WS_PROJ) + C_AG + h * 64;
#define ATTN_C_ARGS \
        const int cgp = du >> 4, qb = du & 15, b = cgp >> 2, hd = cgp & 3, h = 2 * hd + mp; \
        const abf* Q = (const abf*)(ws + WS_QC) + h * 32; const abf* K = (const abf*)(ws + WS_KC) + h * 32; const abf* V = (const abf*)(ws + WS_PROJ) + C_CV + hd * 64; \
        abf* O = (abf*)(ws + WS_H) + 512 + hd * 64; \
        const abf* Gt = mp ? (const abf*)(ws + WS_PROJ) + C_CG + hd * 64 : (const abf*)nullptr;
    attn_body::u32x4 okeep[4] = {};
    if (fix) {
        for (int u = vcu; u < 32 * 16; u += G) { ATTN_A_ARGS
            attn_body::attn_unit<8, true, false>(bA, (long)b * SEQ, qb * 256, Q, 256, K, 128, V, DIN, O, DMODEL, Gt, DIN, okeep, 0, 0.f, 0.f, subln, lds_generic); }
        for (int du = vcu; du < 32 * 16; du += G)
            for (int mp = 0; mp < 2; ++mp) { ATTN_C_ARGS
                attn_body::attn_unit<8, true, true>(bC, (long)b * SEQ, qb * 256, Q, 256, K, 256, V, DIN, O, DMODEL, Gt, DIN, okeep, 1 + mp, lam, oml, subln, lds_generic); }
    } else {
        for (int u = vcu; u < 32 * 16; u += G) { ATTN_A_ARGS
            attn_body::attn_unit<8, false, false>(0.f, (long)b * SEQ, qb * 256, Q, 256, K, 128, V, DIN, O, DMODEL, Gt, DIN, okeep, 0, 0.f, 0.f, subln, lds_generic); }
        for (int du = vcu; du < 32 * 16; du += G)
            for (int mp = 0; mp < 2; ++mp) { ATTN_C_ARGS
                attn_body::attn_unit<8, false, true>(0.f, (long)b * SEQ, qb * 256, Q, 256, K, 256, V, DIN, O, DMODEL, Gt, DIN, okeep, 1 + mp, lam, oml, subln, lds_generic); }
    }
#undef ATTN_A_ARGS
#undef ATTN_C_ARGS
}
#define XB_TMO      128
#define XB_XCNT(j)  (256  + 64 * (j))
#define XB_XSUB(j)  (1280 + 64 * (j))
#define XB_XGEN(j)  (2304 + 64 * (j))
#define XB_TOP      3328
#define XB_TOPGEN   3392
#define XCD_BAR_WORDS 3456
#define XB_SPIN_CAP (1u << 18)

__device__ __forceinline__ unsigned xb_ld(unsigned* p)              { return __hip_atomic_load(p, __ATOMIC_RELAXED, __HIP_MEMORY_SCOPE_AGENT); }
__device__ __forceinline__ unsigned xb_add(unsigned* p, unsigned v) { return __hip_atomic_fetch_add(p, v, __ATOMIC_RELAXED, __HIP_MEMORY_SCOPE_AGENT); }
__device__ __forceinline__ unsigned xb_xcc_id() { return (unsigned)__builtin_amdgcn_s_getreg((3 << 11) | 20) & 0xFu; }
#define XB_SPIN(cond, bar) do { unsigned _sp = 0; while (cond) { __builtin_amdgcn_s_sleep(1); \
    if ((++_sp & 255u) == 0u) { if (xb_ld(&(bar)[XB_TMO])) break; if (_sp > XB_SPIN_CAP) { atomicAdd(&(bar)[XB_TMO], 1u); break; } } } } while (0)

struct XcdBarrier {
    unsigned* bar; unsigned x;
    volatile LAS unsigned* st;
};

__device__ __forceinline__ XcdBarrier xcd_barrier_post(unsigned* bar, volatile LAS unsigned* st) {
    XcdBarrier b; b.bar = bar; b.x = xb_xcc_id(); b.st = st;
    if (threadIdx.x == 0) (void)xb_add(&bar[XB_XCNT(b.x)], 1u);
    return b;
}
__device__ __forceinline__ void xcd_barrier_complete(unsigned* bar, unsigned x, unsigned& nloc, unsigned& nx) {
    const unsigned G = gridDim.x * gridDim.y * gridDim.z;
    unsigned sum, cnt, mine, sp = 0u;
    for (;;) {
        sum = 0u; cnt = 0u; mine = 0u;
#pragma unroll
        for (unsigned j = 0; j < 16; ++j) { const unsigned c = xb_ld(&bar[XB_XCNT(j)]); sum += c; cnt += (c > 0u) ? 1u : 0u; mine = (j == x) ? c : mine; }
        if (sum == G) break;
        __builtin_amdgcn_s_sleep(1);
        if ((++sp & 255u) == 0u) { if (xb_ld(&bar[XB_TMO])) break; if (sp > XB_SPIN_CAP) { atomicAdd(&bar[XB_TMO], 1u); break; } }
    }
    nloc = mine > 0u ? mine : 1u; nx = cnt > 0u ? cnt : 1u;
}

__device__ __forceinline__ void xcd_barrier(const XcdBarrier& b) {
    asm volatile("s_waitcnt vmcnt(0)" ::: "memory");
    __syncthreads();
    if (threadIdx.x == 0) {
        unsigned* bar = b.bar;
        __builtin_amdgcn_s_waitcnt(0);
        unsigned nloc = b.st[0], nx = b.st[1];
        if (nloc == 0u) { xcd_barrier_complete(bar, b.x, nloc, nx); b.st[0] = nloc; b.st[1] = nx; }
        const unsigned old = xb_add(&bar[XB_XSUB(b.x)], 1u);
        const unsigned gen = old / nloc;
        if (old + 1u == (gen + 1u) * nloc) {
            __builtin_amdgcn_fence(__ATOMIC_RELEASE, "agent");
            asm volatile("s_waitcnt vmcnt(0)" ::: "memory");
            const unsigned og = xb_add(&bar[XB_TOP], 1u);
            const unsigned tg = og / nx;
            if (og + 1u == (tg + 1u) * nx) xb_add(&bar[XB_TOPGEN], 1u);
            else XB_SPIN(xb_ld(&bar[XB_TOPGEN]) == tg, bar);
            __builtin_amdgcn_fence(__ATOMIC_ACQUIRE, "agent");
            xb_add(&bar[XB_XGEN(b.x)], 1u);
            asm volatile("s_waitcnt vmcnt(0)" ::: "memory");
        } else {
            XB_SPIN(xb_ld(&bar[XB_XGEN(b.x)]) == gen, bar);
            __builtin_amdgcn_fence(__ATOMIC_ACQUIRE, "agent");
            asm volatile("s_waitcnt vmcnt(0)" ::: "memory");
        }
    }
    __syncthreads();
}

#ifndef PM
#define PM 255
#endif
#ifndef REP_G2L0
#define REP_G2L0 1
#endif
#ifndef REP_PRO
#define REP_PRO 1
#endif
#ifndef REP_NORM
#define REP_NORM 1
#endif
#ifndef REP_G1
#define REP_G1 1
#endif
#ifndef REP_PREP
#define REP_PREP 1
#endif
#ifndef REP_ATTN
#define REP_ATTN 1
#endif
#ifndef REP_HY
#define REP_HY 1
#endif
#ifndef REP_COMB
#define REP_COMB 1
#endif
#ifndef REP_SYNC
#define REP_SYNC 1
#endif
__global__ void __launch_bounds__(NTHR, 2) hymba_fwd(Params Pk) {
    extern __shared__ __attribute__((aligned(16))) unsigned char lds_raw[];
    LAS unsigned char* lds = (LAS unsigned char*)lds_raw;
    cg::grid_group grid = cg::this_grid();
    const int G = gridDim.x, bx = blockIdx.x, vcu = (G % 8 == 0) ? (bx % 8) * (G / 8) + bx / 8 : bx;
    if (threadIdx.x < 8) ((LAS unsigned*)(lds + MISC_OFF))[threadIdx.x] = 0u;
    __syncthreads();
    XcdBarrier bar = xcd_barrier_post((unsigned*)(fresh_params()->ws + WS_BAR), (volatile LAS unsigned*)(lds + MISC_OFF));
#define GSYNC() xcd_barrier(bar)
#if PM & 1
    for (int rp = 0; rp < REP_PRO; ++rp) phase_prologue(lds, vcu, G, rp == 0);
#endif
    if (G == 0x7fffffff) grid.sync();
    GSYNC();
    for (int l = 0; l < DEPTH; ++l) {
#if PM & 2
        for (int rp = 0; rp < REP_NORM; ++rp) phase_norm(l, vcu, G);
#endif
        GSYNC();
#if PM & 4
        for (int rp = 0; rp < REP_G1; ++rp) phase_gemm1(l, lds, G, bx);
#endif
        GSYNC();
#if PM & 16
        for (int rp = 0; rp < REP_ATTN; ++rp) phase_attn(l, (char*)lds_raw, vcu, G);
        __syncthreads();
#endif
#if PM & 32
        for (int rp = 0; rp < REP_HY; ++rp) phase_hyena(l, lds, G);
#endif
        GSYNC();
#if PM & 64
        for (int rp = 0; rp < REP_COMB; ++rp) phase_combine(l, lds, G);
#endif
        GSYNC();
#if PM & 128
        for (int rp = 0; rp < REP_G2L0; ++rp) phase_gemm2(l, lds, G, bx);
#endif
        for (int rp = 0; rp < REP_SYNC; ++rp) GSYNC();
    }
    phase_final(vcu, G);
}

extern "C" void kernel_launch(void* const* d_in, const int* in_sizes, int n_in, void* d_out, int out_size, void* d_ws, size_t ws_size, hipStream_t stream) {
    static int grid = 0;
    if (grid == 0) {
        if (n_in != 26 || out_size != MROWS * DMODEL || ws_size < WS_END) { fprintf(stderr, "kernel_launch: unexpected shapes (n_in %d out %d ws %zu)\n", n_in, out_size, ws_size); grid = -1; return; }
        int dev = 0, cus = 0, per_cu = 0;
        hipGetDevice(&dev); hipDeviceGetAttribute(&cus, hipDeviceAttributeMultiprocessorCount, dev);
        if (hipFuncSetAttribute((const void*)hymba_fwd, hipFuncAttributeMaxDynamicSharedMemorySize, LDS_BYTES) != hipSuccess) { fprintf(stderr, "hipFuncSetAttribute failed\n"); grid = -1; return; }
        if (hipOccupancyMaxActiveBlocksPerMultiprocessor(&per_cu, (const void*)hymba_fwd, NTHR, LDS_BYTES) != hipSuccess || per_cu < 1) { fprintf(stderr, "occupancy query: %d\n", per_cu); per_cu = 1; }
        (void)hipGetLastError();
        grid = cus * 1;
    }
    if (grid < 0) return;
    hipMemsetAsync((char*)d_ws + WS_CTL, 0, CTL_ZERO_BYTES, stream);
    Params p{};
    for (int i = 0; i < 26; ++i) p.in[i] = (const float*)d_in[i];
    p.out = (float*)d_out; p.ws = (unsigned char*)d_ws;
    for (int i = 0; i < 16; ++i) p.inv[i] = (float)pow(10000.0, -(double)i / 16.0);
    for (int l = 0; l < 2; ++l) p.lam_init[l] = (float)(0.8 - 0.6 * exp(-0.3 * (double)l));
    void* args[] = {&p};
    hipError_t e = hipLaunchCooperativeKernel((const void*)hymba_fwd, dim3(grid), dim3(NTHR), args, LDS_BYTES, stream);
    if (e != hipSuccess) fprintf(stderr, "cooperative launch failed: %s (grid %d)\n", hipGetErrorString(e), grid);
}
```
